# Optimizing an MI355X kernel written in HIP

```python
import math
import jax, jax.numpy as jnp
from jax import lax
import numpy as np

D_MODEL = 1024
BATCH = 2
SEQ = 8192
DEPTH = 4

CHUNK = 64
N_A_LAYERS = DEPTH // 2
N_B_LAYERS = DEPTH - N_A_LAYERS
A_INNER = 2 * D_MODEL
A_HEADS = 4
A_HEAD_DIM = A_INNER // A_HEADS
A_CONV = 4
B_INNER = D_MODEL
B_HEADS = 16
B_HEAD_DIM = B_INNER // B_HEADS
B_PAST_CHUNKS = 8
B_PAST = B_PAST_CHUNKS * CHUNK
B_BAND = (B_PAST_CHUNKS + 1) * CHUNK
REL_CLIP = 128
DEEPNORM_ALPHA = (2.0 * DEPTH) ** 0.25
DEEPNORM_BETA = (8.0 * DEPTH) ** -0.25
LN_EPS = 1e-5
GN_EPS = 1e-6

kernel_name = "mlstm_yoco_chunked_relpos_attention_deepnorm"


def layer_norm(x, g, b):
    xf = x.astype(jnp.float32)
    mu = jnp.mean(xf, axis=-1, keepdims=True)
    var = jnp.mean(jnp.square(xf - mu), axis=-1, keepdims=True)
    return ((xf - mu) * lax.rsqrt(var + LN_EPS) * g.astype(jnp.float32) + b.astype(jnp.float32)).astype(x.dtype)


def causal_depthwise_conv(x, w, b):
    k_w = w.shape[0]
    s = x.shape[1]
    xp = jnp.pad(x, ((0, 0), (k_w - 1, 0), (0, 0)))
    out = xp[:, 0:s] * w[0]
    for tap in range(1, k_w):
        out = out + xp[:, tap:tap + s] * w[tap]
    return out + b


def mlstm_chunkwise(q, k, v, i_pre, log_f):
    bsz, s, h, dh = q.shape
    nc = s // CHUNK

    def to_chunks(t):
        t = t.reshape((bsz, nc, CHUNK, h) + t.shape[3:])
        return jnp.moveaxis(t, (1, 3), (0, 2))

    xs = (to_chunks(q), to_chunks(k), to_chunks(v), to_chunks(i_pre), to_chunks(log_f))
    causal = jnp.tril(jnp.ones((CHUNK, CHUNK), dtype=bool))

    def step(carry, inp):
        c_mat, n_vec, m = carry
        q_, k_, v_, i_, lf = inp
        bcum = jnp.cumsum(lf, axis=-1)
        dmat = bcum[..., :, None] - bcum[..., None, :] + i_[..., None, :]
        dmat = jnp.where(causal, dmat, -jnp.inf)
        m_inter = bcum + m[..., None]
        m_t = jnp.maximum(m_inter, jnp.max(dmat, axis=-1))
        w_intra = jnp.exp(dmat - m_t[..., None])
        w_inter = jnp.exp(m_inter - m_t)
        sw = jnp.einsum('bhtd,bhsd->bhts', q_, k_) * w_intra
        num = jnp.einsum('bhts,bhsd->bhtd', sw, v_) + w_inter[..., None] * jnp.einsum('bhtk,bhkd->bhtd', q_, c_mat)
        den = jnp.sum(sw, axis=-1) + w_inter * jnp.einsum('bhtk,bhk->bht', q_, n_vec)
        den = jnp.maximum(jnp.abs(den), jnp.exp(-m_t))
        h_out = num / den[..., None]
        b_last = bcum[..., -1]
        g = b_last[..., None] - bcum + i_
        m_new = jnp.maximum(b_last + m, jnp.max(g, axis=-1))
        decay = jnp.exp(b_last + m - m_new)
        wg = jnp.exp(g - m_new[..., None])
        c_new = decay[..., None, None] * c_mat + jnp.einsum('bhs,bhsk,bhsd->bhkd', wg, k_, v_)
        n_new = decay[..., None] * n_vec + jnp.einsum('bhs,bhsk->bhk', wg, k_)
        return (c_new, n_new, m_new), h_out

    init = (jnp.zeros((bsz, h, dh, dh), jnp.float32),
            jnp.zeros((bsz, h, dh), jnp.float32),
            jnp.zeros((bsz, h), jnp.float32))
    _, hs = lax.scan(step, init, xs)
    return jnp.moveaxis(hs, (0, 2), (1, 3)).reshape(bsz, s, h, dh)


def mlstm_layer(x, w_in, b_gate, conv_w, conv_b, w_q, w_k, w_v, gn_w, skip, w_out):
    bsz, s, _ = x.shape
    u = x @ w_in
    xm, z, o_pre, gates = jnp.split(u, [A_INNER, 2 * A_INNER, 3 * A_INNER], axis=-1)
    gates = (gates + b_gate).astype(jnp.float32)
    i_pre = gates[..., :A_HEADS]
    log_f = jax.nn.log_sigmoid(gates[..., A_HEADS:])
    xc = jax.nn.silu(causal_depthwise_conv(xm, conv_w, conv_b))
    heads = lambda t: t.reshape(bsz, s, A_HEADS, A_HEAD_DIM)
    q = jnp.einsum('bshd,hde->bshe', heads(xc), w_q)
    k = jnp.einsum('bshd,hde->bshe', heads(xc), w_k) * (A_HEAD_DIM ** -0.5)
    v = jnp.einsum('bshd,hde->bshe', heads(xm), w_v)
    h = mlstm_chunkwise(q.astype(jnp.float32), k.astype(jnp.float32), v.astype(jnp.float32), i_pre, log_f)
    mu = jnp.mean(h, axis=-1, keepdims=True)
    var = jnp.mean(jnp.square(h - mu), axis=-1, keepdims=True)
    hn = ((h - mu) * lax.rsqrt(var + GN_EPS)).reshape(bsz, s, A_INNER).astype(x.dtype) * gn_w
    h = jax.nn.sigmoid(o_pre) * hn + skip * xc
    return (h * jax.nn.silu(z)) @ w_out


def shared_band_kv(x, kv_w):
    bsz, s, _ = x.shape
    k, v = jnp.split(x @ kv_w, 2, axis=-1)

    def prep(t):
        t = t.reshape(bsz, s, B_HEADS, B_HEAD_DIM).transpose(0, 2, 1, 3)
        return jnp.pad(t, ((0, 0), (0, 0), (B_PAST, 0), (0, 0)))

    return prep(k), prep(v)


def chunk_attn_layer(x, k_pad, v_pad, w_in, rel_bias, w_out):
    bsz, s, _ = x.shape
    nc = s // CHUNK
    q, g = jnp.split(x @ w_in, 2, axis=-1)
    q = q.reshape(bsz, s, B_HEADS, B_HEAD_DIM).transpose(0, 2, 1, 3) * (B_HEAD_DIM ** -0.5)
    rel = jnp.arange(CHUNK)[:, None] + B_PAST - jnp.arange(B_BAND)[None, :]
    bias = rel_bias[:, jnp.clip(rel, -REL_CLIP, REL_CLIP) + REL_CLIP].astype(jnp.float32)
    key_off = jnp.arange(B_BAND) - B_PAST

    def one_chunk(c):
        start = c * CHUNK
        q_c = lax.dynamic_slice_in_dim(q, start, CHUNK, axis=2)
        k_c = lax.dynamic_slice_in_dim(k_pad, start, B_BAND, axis=2)
        v_c = lax.dynamic_slice_in_dim(v_pad, start, B_BAND, axis=2)
        sc = jnp.einsum('bhqd,bhkd->bhqk', q_c, k_c).astype(jnp.float32) + bias
        valid = (start + key_off) >= 0
        sc = jnp.where(valid, sc, -jnp.inf)
        p = jax.nn.softmax(sc, axis=-1)
        return jnp.einsum('bhqk,bhkd->bhqd', p.astype(v_c.dtype), v_c)

    o = lax.map(one_chunk, jnp.arange(nc))
    o = o.transpose(1, 0, 3, 2, 4).reshape(bsz, s, B_INNER)
    return (o * jax.nn.silu(g)) @ w_out


def setup_inputs(seed: int = 0) -> dict:
    key = jax.random.key(seed)
    ks = jax.random.split(key, 24)
    f32 = jnp.float32
    nrm = lambda k, shape, scale: jax.random.normal(k, shape, f32) * scale
    x = jax.random.normal(ks[0], (BATCH, SEQ, D_MODEL), f32)
    a_w_in = nrm(ks[1], (N_A_LAYERS, D_MODEL, 3 * A_INNER + 2 * A_HEADS), D_MODEL ** -0.5)
    i_bias = nrm(ks[2], (N_A_LAYERS, A_HEADS), 0.1)
    f_bias = jnp.linspace(3.0, 6.0, A_HEADS, dtype=f32)[None, :] + nrm(ks[3], (N_A_LAYERS, A_HEADS), 0.1)
    a_b_gate = jnp.concatenate([i_bias, f_bias], axis=-1)
    a_conv_w = nrm(ks[4], (N_A_LAYERS, A_CONV, A_INNER), A_CONV ** -0.5)
    a_conv_b = nrm(ks[5], (N_A_LAYERS, A_INNER), 0.02)
    a_w_q = nrm(ks[6], (N_A_LAYERS, A_HEADS, A_HEAD_DIM, A_HEAD_DIM), A_HEAD_DIM ** -0.5)
    a_w_k = nrm(ks[7], (N_A_LAYERS, A_HEADS, A_HEAD_DIM, A_HEAD_DIM), A_HEAD_DIM ** -0.5)
    a_w_v = nrm(ks[8], (N_A_LAYERS, A_HEADS, A_HEAD_DIM, A_HEAD_DIM), A_HEAD_DIM ** -0.5)
    a_gn_w = 1.0 + nrm(ks[9], (N_A_LAYERS, A_INNER), 0.02)
    a_skip = 1.0 + nrm(ks[10], (N_A_LAYERS, A_INNER), 0.02)
    a_w_out = nrm(ks[11], (N_A_LAYERS, A_INNER, D_MODEL), DEEPNORM_BETA * A_INNER ** -0.5)
    a_ln_g = 1.0 + nrm(ks[12], (N_A_LAYERS, D_MODEL), 0.02)
    a_ln_b = nrm(ks[13], (N_A_LAYERS, D_MODEL), 0.02)
    kv_w = nrm(ks[14], (D_MODEL, 2 * B_INNER), D_MODEL ** -0.5)
    b_w_in = nrm(ks[15], (N_B_LAYERS, D_MODEL, 2 * B_INNER), D_MODEL ** -0.5)
    b_rel_bias = nrm(ks[16], (N_B_LAYERS, B_HEADS, 2 * REL_CLIP + 1), 0.1)
    b_w_out = nrm(ks[17], (N_B_LAYERS, B_INNER, D_MODEL), DEEPNORM_BETA * B_INNER ** -0.5)
    b_ln_g = 1.0 + nrm(ks[18], (N_B_LAYERS, D_MODEL), 0.02)
    b_ln_b = nrm(ks[19], (N_B_LAYERS, D_MODEL), 0.02)
    return {"x": x, "a_w_in": a_w_in, "a_b_gate": a_b_gate, "a_conv_w": a_conv_w,
            "a_conv_b": a_conv_b, "a_w_q": a_w_q, "a_w_k": a_w_k, "a_w_v": a_w_v,
            "a_gn_w": a_gn_w, "a_skip": a_skip, "a_w_out": a_w_out, "a_ln_g": a_ln_g,
            "a_ln_b": a_ln_b, "kv_w": kv_w, "b_w_in": b_w_in, "b_rel_bias": b_rel_bias,
            "b_w_out": b_w_out, "b_ln_g": b_ln_g, "b_ln_b": b_ln_b}


def reference(x, a_w_in, a_b_gate, a_conv_w, a_conv_b, a_w_q, a_w_k, a_w_v, a_gn_w, a_skip,
              a_w_out, a_ln_g, a_ln_b, kv_w, b_w_in, b_rel_bias, b_w_out, b_ln_g, b_ln_b):
    k_pad = None
    v_pad = None
    for layer in range(DEPTH):
        if layer < N_A_LAYERS:
            l = layer
            y = mlstm_layer(x, a_w_in[l], a_b_gate[l], a_conv_w[l], a_conv_b[l], a_w_q[l],
                            a_w_k[l], a_w_v[l], a_gn_w[l], a_skip[l], a_w_out[l])
            x = layer_norm(DEEPNORM_ALPHA * x + y, a_ln_g[l], a_ln_b[l])
            if layer == N_A_LAYERS - 1:
                k_pad, v_pad = shared_band_kv(x, kv_w)
        else:
            l = layer - N_A_LAYERS
            y = chunk_attn_layer(x, k_pad, v_pad, b_w_in[l], b_rel_bias[l], b_w_out[l])
            x = layer_norm(DEEPNORM_ALPHA * x + y, b_ln_g[l], b_ln_b[l])
    return x
```

```cpp
#include <hip/hip_runtime.h>
#include <hip/hip_cooperative_groups.h>
#include <cstdint>
#include <cstdio>
namespace cg = cooperative_groups;

#define LAS __attribute__((address_space(3)))
typedef unsigned short bf16_t;
typedef short bf16x8 __attribute__((ext_vector_type(8)));
typedef short s16x4 __attribute__((ext_vector_type(4)));
typedef float f32x4 __attribute__((ext_vector_type(4)));
typedef unsigned u32x4 __attribute__((ext_vector_type(4)));
typedef unsigned u32x2 __attribute__((ext_vector_type(2)));
typedef float f32x2_t __attribute__((ext_vector_type(2)));
typedef __bf16 bf16x2_t __attribute__((ext_vector_type(2)));

constexpr int M = 16384, DM = 1024, AI = 2048, SEQ = 8192, NCH = 128;
constexpr float ALPHA = 1.681792830507429f;
constexpr size_t MiB = 1u << 20;
constexpr size_t WS_IPRE = 0, WS_LFS = 256 * 1024, WS_BCUM = 512 * 1024, WS_AARR = 768 * 1024, WS_AMAX = 1024 * 1024,
                 WS_DENSUM = 1280 * 1024, WS_ECLAMP = 1536 * 1024, WS_DEN = 1792 * 1024;
constexpr size_t WS_GNSTAT = 2 * MiB, WS_BLAST = 2 * MiB + 512 * 1024, WS_AM63 = WS_BLAST + 4096, WS_DECAY = WS_AM63 + 4096;
constexpr size_t WS_KSUM = 3 * MiB, WS_SW = 5 * MiB, WS_CST = 9 * MiB, WS_NST = 17 * MiB;
constexpr size_t WS_W = 18 * MiB;
constexpr size_t WS_WXM = WS_W, WS_WV = WS_W + 4 * MiB, WS_WQK = WS_W + 6 * MiB, WS_WOUT = WS_W + 10 * MiB;
constexpr size_t WS_WZO = WS_CST;
constexpr size_t WS_XN = 32 * MiB, WS_BUF0 = 64 * MiB, WS_BUF1 = 128 * MiB, WS_BUF2 = 192 * MiB, WS_END = 256 * MiB;
constexpr size_t WS_BW0 = 64 * MiB  , WS_BVW = 70 * MiB  , WS_BO0 = 72 * MiB  , WS_BW1 = 74 * MiB  , WS_BO1 = 78 * MiB  ;
constexpr size_t WS_QB = 80 * MiB, WS_GB = 112 * MiB, WS_KB = 144 * MiB, WS_VT = 176 * MiB, WS_OG = 208 * MiB;

constexpr int LDS_BYTES = 147456;

__device__ __forceinline__ unsigned cvtpk(float lo, float hi) { f32x2_t v = {lo, hi}; bf16x2_t b = __builtin_convertvector(v, bf16x2_t); return __builtin_bit_cast(unsigned, b); }
__device__ __forceinline__ float bflo(unsigned u) { return __uint_as_float(u << 16); }
__device__ __forceinline__ float bfhi(unsigned u) { return __uint_as_float(u & 0xffff0000u); }
__device__ __forceinline__ float bf2f(unsigned short u) { return __uint_as_float(((unsigned)u) << 16); }
__device__ __forceinline__ float wave_sum(float v) {
#pragma unroll
    for (int o = 1; o < 64; o <<= 1) v += __shfl_xor(v, o);
    return v;
}
__device__ __forceinline__ float sigmoidf_(float x) { return 1.0f / (1.0f + __expf(-x)); }
__device__ __forceinline__ s16x4 tr16(const LAS unsigned char* p) { return __builtin_bit_cast(s16x4, __builtin_amdgcn_ds_read_tr16_b64_v4i16((LAS s16x4*)p)); }

namespace pg8 {
constexpr int BM = 256, BK = 64, HALF = 128, HTB = HALF * BK * 2, STAGE_BYTES = 8 * HTB, NXCD = 8, WGM = 8;
__host__ __device__ __forceinline__ int lds_byte(int r, int c) { const int st = (r >> 4) * 2 + (c >> 5), rr = r & 15, cc = c & 31, ob = rr * 64 + cc * 2; return st * 1024 + (ob ^ (((ob >> 9) & 1) << 5)); }
__host__ __device__ __forceinline__ void stage_rc(int b, int& R, int& C) { const int st = b / 1024, sb = b % 1024, swz = sb ^ (((sb >> 9) & 1) << 5); R = (st >> 1) * 16 + swz / 64; C = (st & 1) * 32 + (swz % 64) / 2; }

struct Unit { int pm, pn; const char* a; const char* b; };
struct Sched {
    int nM, nN, nwg, G, c;
    const char* A; const char* B; size_t a_tstep, b_tstep;
    int seg;
    int grp_shift; size_t a_grp_bytes;
    __device__ __forceinline__ void init(int nM_, int nN_, int G_, int c_, const void* A_, const void* B_, int lda, int ldb) {
        nM = nM_; nN = nN_; nwg = nM * nN; G = G_; c = c_; A = (const char*)A_; B = (const char*)B_;
        a_tstep = (size_t)BM * lda * 2; b_tstep = (size_t)BM * ldb * 2; seg = -1; grp_shift = 30; a_grp_bytes = 0;
    }
    __device__ __forceinline__ bool next(int i, Unit& u) const {
        const long L = (long)i * G + c; if (L >= nwg) return false;
        int wgid = (int)L; { const int q = nwg / NXCD, r = nwg % NXCD, xcd = wgid % NXCD, off = wgid / NXCD; wgid = (xcd < r ? xcd * (q + 1) : r * (q + 1) + (xcd - r) * q) + off; }
        const int nig = WGM * nN, gid = wgid / nig, fm = gid * WGM, gsz = (nM - fm) < WGM ? (nM - fm) : WGM;
        int pmv = fm + ((wgid % nig) % gsz); u.pn = (wgid % nig) / gsz;
        u.pm = seg < 0 ? pmv : ((pmv >> 4) * 32 + 16 * seg + (pmv & 15));
        u.a = A + (size_t)u.pm * a_tstep + (size_t)(u.pn >> grp_shift) * a_grp_bytes; u.b = B + (size_t)u.pn * b_tstep; return true;
    }
};

template <class Epi>
__device__ __forceinline__ void gemm_phase(LAS unsigned char* lds, const Sched& S, int K, int lda, int ldb, const Epi& E) {
    int tid_ = threadIdx.x; asm volatile("" : "+v"(tid_));
    const int tid = tid_, wid = __builtin_amdgcn_readfirstlane(tid >> 6), lane = tid & 63, wr = wid >> 2, wc = wid & 3, fr = lane & 15, fq = lane >> 4;
    const int nt = K / BK;
    unsigned voffA[2], voffB[2];
#pragma unroll
    for (int i = 0; i < 2; ++i) { int R, C; stage_rc(tid * 16 + i * 8192, R, C); voffA[i] = (unsigned)(R * lda + C) * 2u; voffB[i] = (unsigned)(R * ldb + C) * 2u; }
    const size_t kstep = (size_t)(BK * 2);
    const size_t hstepA = (size_t)HALF * lda * 2, hstepB = (size_t)HALF * ldb * 2;
    const unsigned ldsw = (unsigned)wid * 1024u;
    const int aoff = lds_byte(wr * 64 + fr, fq * 8), boff = lds_byte(wc * 32 + fr, fq * 8);
#define PG8_SA(b, h) (((b) * 2 + (h)) * HTB)
#define PG8_SB(b, h) ((4 + (b) * 2 + (h)) * HTB)
#define PG8_STAGE(bufoff, gbase, voff) do { _Pragma("unroll") for (int _i = 0; _i < 2; ++_i) \
        __builtin_amdgcn_global_load_lds((const unsigned*)((const char*)(gbase) + (voff)[_i]), (LAS unsigned*)(lds + (bufoff) + ldsw + _i * 8192), 16, 0, 0); } while (0)
#define PG8_LDA(dst, b, h) do { _Pragma("unroll") for (int m = 0; m < 4; ++m) _Pragma("unroll") for (int k = 0; k < 2; ++k) dst[m][k] = *(const LAS bf16x8*)(lds + PG8_SA(b, h) + aoff + m * 2048 + k * 1024); } while (0)
#define PG8_LDB(dst, b, h) do { _Pragma("unroll") for (int n = 0; n < 2; ++n) _Pragma("unroll") for (int k = 0; k < 2; ++k) dst[n][k] = *(const LAS bf16x8*)(lds + PG8_SB(b, h) + boff + n * 2048 + k * 1024); } while (0)
#define PG8_MMA(ai, bj, At, Bt) do { __builtin_amdgcn_s_setprio(1); _Pragma("unroll") for (int m = 0; m < 4; ++m) _Pragma("unroll") for (int n = 0; n < 2; ++n) _Pragma("unroll") for (int k = 0; k < 2; ++k) \
        acc[ai][bj][m][n] = __builtin_amdgcn_mfma_f32_16x16x32_bf16(Bt[n][k], At[m][k], acc[ai][bj][m][n], 0, 0, 0); __builtin_amdgcn_s_setprio(0); } while (0)
#define PG8_WAIT_V(n) asm volatile("s_waitcnt vmcnt(" #n ")" ::: "memory")
#define PG8_WAIT_L(n) asm volatile("s_waitcnt lgkmcnt(" #n ")" ::: "memory")
#define PG8_BAR __builtin_amdgcn_s_barrier()
#define PG8_SCHED __builtin_amdgcn_sched_barrier(0)
    Unit cur, nxt; int ui = 0;
    if (!S.next(0, cur)) return;
    f32x4 acc[2][2][4][2];
#pragma unroll
    for (int a = 0; a < 2; ++a)
#pragma unroll
        for (int b = 0; b < 2; ++b)
#pragma unroll
            for (int m = 0; m < 4; ++m)
#pragma unroll
                for (int n = 0; n < 2; ++n) acc[a][b][m][n] = (f32x4){0.f, 0.f, 0.f, 0.f};
    bf16x8 At[4][2], B0[2][2], B1[2][2];
    const char* cA = cur.a; const char* cB = cur.b;
    PG8_STAGE(PG8_SB(0, 0), cB, voffB); PG8_STAGE(PG8_SB(0, 1), cB + hstepB, voffB); PG8_STAGE(PG8_SA(0, 0), cA, voffA); PG8_STAGE(PG8_SA(0, 1), cA + hstepA, voffA);
    if (wr == 1) PG8_BAR;
    PG8_WAIT_V(2); PG8_BAR;
    PG8_STAGE(PG8_SB(1, 0), cB + kstep, voffB); PG8_STAGE(PG8_SA(1, 0), cA + kstep, voffA); PG8_STAGE(PG8_SB(1, 1), cB + hstepB + kstep, voffB);
    PG8_WAIT_V(6); PG8_BAR;
    for (;;) {
        const bool has_next = S.next(ui + 1, nxt);
        const char* nA = has_next ? nxt.a : cA; const char* nB = has_next ? nxt.b : cB;
        for (int t = 0; t < nt; t += 2) {
            const bool last = (t == nt - 2);
            const char* a1 = cA + (size_t)(t + 1) * kstep;
            const char* a2 = last ? nA : cA + (size_t)(t + 2) * kstep; const char* b2 = last ? nB : cB + (size_t)(t + 2) * kstep;
            const char* a3 = a2 + kstep; const char* b3 = b2 + kstep;
            PG8_LDB(B0, 0, 0); PG8_LDB(B1, 0, 1); PG8_SCHED; PG8_LDA(At, 0, 0); PG8_STAGE(PG8_SA(1, 1), a1 + hstepA, voffA);
            PG8_WAIT_V(8); PG8_WAIT_L(0); PG8_BAR; PG8_MMA(0, 0, At, B0); PG8_MMA(0, 1, At, B1); PG8_BAR; PG8_SCHED;
            PG8_LDA(At, 0, 1); PG8_STAGE(PG8_SB(0, 0), b2, voffB); PG8_STAGE(PG8_SB(0, 1), b2 + hstepB, voffB); PG8_STAGE(PG8_SA(0, 0), a2, voffA);
            PG8_WAIT_V(8); PG8_WAIT_L(0); PG8_BAR; PG8_MMA(1, 0, At, B0); PG8_MMA(1, 1, At, B1); PG8_BAR; PG8_SCHED;
            PG8_LDB(B0, 1, 0); PG8_LDB(B1, 1, 1); PG8_SCHED; PG8_LDA(At, 1, 0); PG8_STAGE(PG8_SA(0, 1), a2 + hstepA, voffA);
            PG8_WAIT_V(8); PG8_WAIT_L(0); PG8_BAR; PG8_MMA(0, 0, At, B0); PG8_MMA(0, 1, At, B1); PG8_BAR; PG8_SCHED;
            PG8_LDA(At, 1, 1); PG8_STAGE(PG8_SB(1, 0), b3, voffB); PG8_STAGE(PG8_SB(1, 1), b3 + hstepB, voffB); PG8_STAGE(PG8_SA(1, 0), a3, voffA);
            PG8_WAIT_V(8); PG8_WAIT_L(0); PG8_BAR; PG8_MMA(1, 0, At, B0); PG8_MMA(1, 1, At, B1); PG8_BAR; PG8_SCHED;
        }
        if (wr == 0) PG8_BAR;
        E(acc, cur, wr, wc, fr, fq);
        if (!has_next) break;
#pragma unroll
        for (int a = 0; a < 2; ++a)
#pragma unroll
            for (int b = 0; b < 2; ++b)
#pragma unroll
                for (int m = 0; m < 4; ++m)
#pragma unroll
                    for (int n = 0; n < 2; ++n) acc[a][b][m][n] = (f32x4){0.f, 0.f, 0.f, 0.f};
        cur = nxt; cA = nA; cB = nB; ++ui;
        if (wr == 1) PG8_BAR;
    }
    PG8_WAIT_V(0);
    PG8_BAR;
#undef PG8_SA
#undef PG8_SB
#undef PG8_STAGE
#undef PG8_LDA
#undef PG8_LDB
#undef PG8_MMA
#undef PG8_WAIT_V
#undef PG8_WAIT_L
#undef PG8_BAR
#undef PG8_SCHED
}
}
using pg8::Unit; using pg8::Sched;

#define EPI_LOOP_BEGIN \
    _Pragma("unroll") for (int ai = 0; ai < 2; ++ai) _Pragma("unroll") for (int m = 0; m < 4; ++m) { const int row = u.pm * 256 + ai * 128 + wr * 64 + m * 16 + fr; \
    _Pragma("unroll") for (int bj = 0; bj < 2; ++bj) _Pragma("unroll") for (int n = 0; n < 2; ++n) { const int col = u.pn * 256 + bj * 128 + wc * 32 + n * 16 + fq * 4; const f32x4 v = acc[ai][bj][m][n];
#define EPI_LOOP_END } }

struct EpiPlain { bf16_t* O; size_t ldc;
    __device__ __forceinline__ void operator()(const f32x4 (&acc)[2][2][4][2], const Unit& u, int wr, int wc, int fr, int fq) const {
        EPI_LOOP_BEGIN
            u32x2 w; w.x = cvtpk(v[0], v[1]); w.y = cvtpk(v[2], v[3]); *(u32x2*)(O + (size_t)row * ldc + col) = w;
        EPI_LOOP_END
    } };
struct EpiQK { bf16_t* Q; size_t kstride; int seg;
    __device__ __forceinline__ void operator()(const f32x4 (&acc)[2][2][4][2], const Unit& u, int wr, int wc, int fr, int fq) const {
        EPI_LOOP_BEGIN
            const int orow = (row >> 13) * 4096 + ((row & 8191) - 4096 * seg); const int head = col >> 10, e = col & 1023;
            bf16_t* dst = Q + (size_t)(e >> 9) * kstride + (size_t)orow * 2048 + head * 512 + (e & 511);
            u32x2 w; w.x = cvtpk(v[0], v[1]); w.y = cvtpk(v[2], v[3]); *(u32x2*)dst = w;
        EPI_LOOP_END
    } };
struct EpiSplit3 { bf16_t* O0; size_t stride;
    __device__ __forceinline__ void operator()(const f32x4 (&acc)[2][2][4][2], const Unit& u, int wr, int wc, int fr, int fq) const {
        EPI_LOOP_BEGIN
            const int t = col >> 10; bf16_t* dst = O0 + (size_t)t * stride + (size_t)row * 1024 + (col & 1023);
            u32x2 w; w.x = cvtpk(v[0], v[1]); w.y = cvtpk(v[2], v[3]); *(u32x2*)dst = w;
        EPI_LOOP_END
    } };
struct EpiResid { float* X;
    __device__ __forceinline__ void operator()(const f32x4 (&acc)[2][2][4][2], const Unit& u, int wr, int wc, int fr, int fq) const {
        EPI_LOOP_BEGIN
            f32x4* p = (f32x4*)(X + (size_t)row * 1024 + col); const f32x4 x = *p; *p = x * ALPHA + v;
        EPI_LOOP_END
    } };
struct EpiGate { const bf16_t* NUM; const bf16_t* XC; const float* gnstat; const float* gnw; const float* skip; bf16_t* HG;
    __device__ __forceinline__ void operator()(const f32x4 (&acc)[2][2][4][2], const Unit& u, int wr, int wc, int fr, int fq) const {
#pragma unroll
        for (int ai = 0; ai < 2; ++ai)
#pragma unroll
            for (int m = 0; m < 4; ++m) { const int row = u.pm * 256 + ai * 128 + wr * 64 + m * 16 + fr;
#pragma unroll
                for (int n = 0; n < 2; ++n) { const int c = u.pn * 128 + wc * 32 + n * 16 + fq * 4; const int head = c >> 9;
                    const f32x4 z = acc[ai][0][m][n], o = acc[ai][1][m][n];
                    const u32x2 nm = *(const u32x2*)(NUM + (size_t)row * 2048 + c), xc = *(const u32x2*)(XC + (size_t)row * 2048 + c);
                    const float mean = gnstat[((size_t)row * 4 + head) * 2], rstd = gnstat[((size_t)row * 4 + head) * 2 + 1];
                    const f32x4 gw = *(const f32x4*)(gnw + c), sk = *(const f32x4*)(skip + c);
                    const float nv[4] = {bflo(nm.x), bfhi(nm.x), bflo(nm.y), bfhi(nm.y)}, xv[4] = {bflo(xc.x), bfhi(xc.x), bflo(xc.y), bfhi(xc.y)};
                    float r[4];
#pragma unroll
                    for (int e = 0; e < 4; ++e) { const float hn = (nv[e] - mean) * rstd * gw[e]; r[e] = (sigmoidf_(o[e]) * hn + sk[e] * xv[e]) * (z[e] * sigmoidf_(z[e])); }
                    u32x2 w; w.x = cvtpk(r[0], r[1]); w.y = cvtpk(r[2], r[3]); *(u32x2*)(HG + (size_t)row * 2048 + c) = w; } }
    } };

struct Ctx { int tid, lane, wid, gw, NGW; LAS unsigned char* lds; };
__device__ __forceinline__ Ctx relaunder(const Ctx& C0) { Ctx C = C0; int t = threadIdx.x; asm volatile("" : "+v"(t)); C.tid = t; C.lane = t & 63; C.wid = __builtin_amdgcn_readfirstlane(t >> 6); C.gw = blockIdx.x * 8 + C.wid; return C; }

__device__ __forceinline__ void tr_block(const float* W, int ldw, int scol, bf16_t* WT, int Kd, int drow, int k0, float scale, LAS float* scr, int lane) {
#pragma unroll 8
    for (int i = 0; i < 32; ++i) { const int kk = 2 * i + (lane >> 5); scr[kk * 33 + (lane & 31)] = W[(size_t)(k0 + kk) * ldw + scol + (lane & 31)] * scale; }
    asm volatile("s_waitcnt lgkmcnt(0)" ::: "memory");
    const int c = lane & 7;
#pragma unroll
    for (int j = 0; j < 4; ++j) { const int n = (lane >> 3) + 8 * j; const LAS float* s = scr + (8 * c) * 33 + n;
        u32x4 o; o.x = cvtpk(s[0 * 33], s[1 * 33]); o.y = cvtpk(s[2 * 33], s[3 * 33]); o.z = cvtpk(s[4 * 33], s[5 * 33]); o.w = cvtpk(s[6 * 33], s[7 * 33]);
        *(u32x4*)(WT + (size_t)(drow + n) * Kd + k0 + 8 * c) = o; }
    asm volatile("s_waitcnt lgkmcnt(0)" ::: "memory");
}
__device__ __forceinline__ void tr_matrix(const Ctx& C, const float* W, int ldw, int K, int ncols, int scol0, bf16_t* WT, int drow0, float scale) {
    LAS float* scr = (LAS float*)(C.lds + C.wid * 16384);
    const int nb = ncols / 32, items = (K / 64) * nb;
    for (int it = C.gw; it < items; it += C.NGW) { const int kb = it / nb, b = it % nb; tr_block(W, ldw, scol0 + 32 * b, WT, K, drow0 + 32 * b, 64 * kb, scale, scr, C.lane); }
}
struct AW { const float *w_in, *w_q, *w_k, *w_v, *w_out; };
__device__ __forceinline__ void convert_a_weights(const Ctx& C0, const AW& w, unsigned char* ws) {
    const Ctx C = relaunder(C0);
    tr_matrix(C, w.w_in, 6152, 1024, 2048, 0, (bf16_t*)(ws + WS_WXM), 0, 1.f);
    for (int h = 0; h < 4; ++h) {
        tr_matrix(C, w.w_v + (size_t)h * 262144, 512, 512, 512, 0, (bf16_t*)(ws + WS_WV), h * 512, 1.f);
        tr_matrix(C, w.w_q + (size_t)h * 262144, 512, 512, 512, 0, (bf16_t*)(ws + WS_WQK), h * 1024, 1.f);
        tr_matrix(C, w.w_k + (size_t)h * 262144, 512, 512, 512, 0, (bf16_t*)(ws + WS_WQK), h * 1024 + 512, 0.044194173824159216f);
    }
    tr_matrix(C, w.w_out, 1024, 2048, 1024, 0, (bf16_t*)(ws + WS_WOUT), 0, 1.f);
}
__device__ __forceinline__ void convert_zo_weights(const Ctx& C0, const float* w_in, unsigned char* ws) {
    const Ctx C = relaunder(C0);
    LAS float* scr = (LAS float*)(C.lds + C.wid * 16384);
    for (int it = C.gw; it < 2048; it += C.NGW) { const int pn = it >> 7, zo = (it >> 6) & 1, sub = it & 63, kb = sub >> 2, b = sub & 3;
        tr_block(w_in, 6152, 2048 + zo * 2048 + 128 * pn + 32 * b, (bf16_t*)(ws + WS_WZO), 1024, 256 * pn + 128 * zo + 32 * b, 64 * kb, 1.f, scr, C.lane); }
}
__device__ __forceinline__ void convert_b_weights(const Ctx& C0, const float* kv_w, const float* b_w_in, const float* b_w_out, unsigned char* ws) {
    const Ctx C = relaunder(C0);
    tr_matrix(C, b_w_in, 2048, 1024, 1024, 0, (bf16_t*)(ws + WS_BW0), 0, 0.125f);
    tr_matrix(C, b_w_in, 2048, 1024, 1024, 1024, (bf16_t*)(ws + WS_BW0), 1024, 1.f);
    tr_matrix(C, kv_w, 2048, 1024, 1024, 0, (bf16_t*)(ws + WS_BW0), 2048, 1.f);
    tr_matrix(C, kv_w, 2048, 1024, 1024, 1024, (bf16_t*)(ws + WS_BVW), 0, 1.f);
    tr_matrix(C, b_w_out, 1024, 1024, 1024, 0, (bf16_t*)(ws + WS_BO0), 0, 1.f);
    tr_matrix(C, b_w_in + (size_t)1024 * 2048, 2048, 1024, 1024, 0, (bf16_t*)(ws + WS_BW1), 0, 0.125f);
    tr_matrix(C, b_w_in + (size_t)1024 * 2048, 2048, 1024, 1024, 1024, (bf16_t*)(ws + WS_BW1), 1024, 1.f);
    tr_matrix(C, b_w_out + (size_t)1024 * 1024, 1024, 1024, 1024, 0, (bf16_t*)(ws + WS_BO1), 0, 1.f);
}

__device__ __forceinline__ void rows_ln(const Ctx& C0, const float* src, float* dst, bf16_t* xn, const float* g, const float* bta) {
    const Ctx C = relaunder(C0);
    for (int r = C.gw; r < M; r += C.NGW) {
        const f32x4* xr = (const f32x4*)(src + (size_t)r * DM) + C.lane;
        f32x4 v[4]; float s = 0.f;
#pragma unroll
        for (int j = 0; j < 4; ++j) { v[j] = xr[64 * j]; s += (v[j][0] + v[j][1]) + (v[j][2] + v[j][3]); }
        if (g) {
            const float mean = wave_sum(s) * (1.f / DM); float s2 = 0.f;
#pragma unroll
            for (int j = 0; j < 4; ++j) { v[j] = v[j] - mean; s2 += (v[j][0] * v[j][0] + v[j][1] * v[j][1]) + (v[j][2] * v[j][2] + v[j][3] * v[j][3]); }
            const float rstd = 1.f / sqrtf(wave_sum(s2) * (1.f / DM) + 1e-5f);
#pragma unroll
            for (int j = 0; j < 4; ++j) { const f32x4 gg = *((const f32x4*)g + C.lane + 64 * j), bb = *((const f32x4*)bta + C.lane + 64 * j); v[j] = v[j] * rstd * gg + bb; }
        }
        f32x4* o = (f32x4*)(dst + (size_t)r * DM) + C.lane; u32x2* o8 = (u32x2*)(xn + (size_t)r * DM) + C.lane;
#pragma unroll
        for (int j = 0; j < 4; ++j) { o[64 * j] = v[j]; u32x2 w; w.x = cvtpk(v[j][0], v[j][1]); w.y = cvtpk(v[j][2], v[j][3]); o8[64 * j] = w; }
    }
}

__device__ __forceinline__ void phase_a2(const Ctx& C0, const float* Xf, const float* w_in, const float* b_gate, const float* conv_w, const float* conv_b,
                                         const bf16_t* XM, bf16_t* XCb, unsigned char* ws) {
    const Ctx C = relaunder(C0);
    LAS float* Wg = (LAS float*)C.lds;
    LAS float* gl = (LAS float*)(C.lds + 32768);
    float* ipre = (float*)(ws + WS_IPRE); float* bcum = (float*)(ws + WS_BCUM); float* aarr = (float*)(ws + WS_AARR); float* amax = (float*)(ws + WS_AMAX);
    float* blast = (float*)(ws + WS_BLAST); float* am63 = (float*)(ws + WS_AM63);
    (void)ipre;
    for (int k = C.tid; k < 1024; k += 512) { const f32x4 a = *(const f32x4*)(w_in + (size_t)k * 6152 + 6144), b = *(const f32x4*)(w_in + (size_t)k * 6152 + 6148);
        *(LAS f32x4*)(Wg + k * 8) = a; *(LAS f32x4*)(Wg + k * 8 + 4) = b; }
    __syncthreads();
    for (int rb = blockIdx.x; rb < 256; rb += gridDim.x) {
        for (int i = 0; i < 8; ++i) { const int rl = 8 * C.wid + i, r = 64 * rb + rl;
            float acc[8];
#pragma unroll
            for (int g = 0; g < 8; ++g) acc[g] = 0.f;
#pragma unroll
            for (int jj = 0; jj < 4; ++jj) { const f32x4 xv = *(const f32x4*)(Xf + (size_t)r * DM + 256 * jj + 4 * C.lane);
#pragma unroll
                for (int e = 0; e < 4; ++e) { const int k = 256 * jj + 4 * C.lane + e; const f32x4 w0 = *(const LAS f32x4*)(Wg + k * 8), w1 = *(const LAS f32x4*)(Wg + k * 8 + 4);
#pragma unroll
                    for (int g = 0; g < 4; ++g) { acc[g] += xv[e] * w0[g]; acc[4 + g] += xv[e] * w1[g]; } } }
#pragma unroll
            for (int g = 0; g < 8; ++g) acc[g] = wave_sum(acc[g]);
            if (C.lane < 8) { float v = acc[0];
#pragma unroll
                for (int g = 1; g < 8; ++g) v = (C.lane == g) ? acc[g] : v;
                v += b_gate[C.lane];
                if (C.lane >= 4) v = fminf(v, 0.f) - log1pf(__expf(-fabsf(v)));
                gl[rl * 8 + C.lane] = v; }
        }
        __syncthreads();
        if (C.wid < 4) { const int h = C.wid, t = C.lane, row = 64 * rb + t;
            const float ig = gl[t * 8 + h], lf = gl[t * 8 + 4 + h];
            float bc = lf;
#pragma unroll
            for (int off = 1; off < 64; off <<= 1) { const float v = __shfl_up(bc, off); if (t >= off) bc += v; }
            const float a = ig - bc; float amx = a;
#pragma unroll
            for (int off = 1; off < 64; off <<= 1) { const float v = __shfl_up(amx, off); if (t >= off) amx = fmaxf(amx, v); }
            bcum[row * 4 + h] = bc; aarr[row * 4 + h] = a; amax[row * 4 + h] = amx;
            if (t == 63) { const int bh = (rb >> 7) * 4 + h, c = rb & 127; blast[bh * 128 + c] = bc; am63[bh * 128 + c] = amx; }
        }
        { const int cgp = C.tid & 255, hf = C.tid >> 8, c0 = 8 * cgp, r0 = 64 * rb + 32 * hf;
            float w[4][8], bs[8];
#pragma unroll
            for (int tp = 0; tp < 4; ++tp) { const f32x4 a = *(const f32x4*)(conv_w + tp * 2048 + c0), b = *(const f32x4*)(conv_w + tp * 2048 + c0 + 4);
#pragma unroll
                for (int e = 0; e < 4; ++e) { w[tp][e] = a[e]; w[tp][4 + e] = b[e]; } }
            { const f32x4 a = *(const f32x4*)(conv_b + c0), b = *(const f32x4*)(conv_b + c0 + 4);
#pragma unroll
                for (int e = 0; e < 4; ++e) { bs[e] = a[e]; bs[4 + e] = b[e]; } }
            u32x4 x0 = {0, 0, 0, 0}, x1 = x0, x2 = x0;
            if ((r0 & 8191) != 0) { x0 = *(const u32x4*)(XM + (size_t)(r0 - 3) * 2048 + c0); x1 = *(const u32x4*)(XM + (size_t)(r0 - 2) * 2048 + c0); x2 = *(const u32x4*)(XM + (size_t)(r0 - 1) * 2048 + c0); }
            for (int i = 0; i < 32; ++i) { const u32x4 x3 = *(const u32x4*)(XM + (size_t)(r0 + i) * 2048 + c0);
                float o[8];
#pragma unroll
                for (int p = 0; p < 4; ++p) {
                    o[2 * p] = bs[2 * p] + w[0][2 * p] * bflo(x0[p]) + w[1][2 * p] * bflo(x1[p]) + w[2][2 * p] * bflo(x2[p]) + w[3][2 * p] * bflo(x3[p]);
                    o[2 * p + 1] = bs[2 * p + 1] + w[0][2 * p + 1] * bfhi(x0[p]) + w[1][2 * p + 1] * bfhi(x1[p]) + w[2][2 * p + 1] * bfhi(x2[p]) + w[3][2 * p + 1] * bfhi(x3[p]); }
#pragma unroll
                for (int e = 0; e < 8; ++e) o[e] = o[e] * sigmoidf_(o[e]);
                u32x4 ov; ov.x = cvtpk(o[0], o[1]); ov.y = cvtpk(o[2], o[3]); ov.z = cvtpk(o[4], o[5]); ov.w = cvtpk(o[6], o[7]);
                *(u32x4*)(XCb + (size_t)(r0 + i) * 2048 + c0) = ov; x0 = x1; x1 = x2; x2 = x3; }
        }
        __syncthreads();
    }
}

__device__ __forceinline__ void phase_pa(const Ctx& C0, int seg, bf16_t* Qs, bf16_t* Ks, unsigned char* ws) {
    const Ctx C = relaunder(C0);
    LAS float* sa = (LAS float*)C.lds; LAS float* sM = sa + 64; LAS float* swi = sa + 128; LAS float* swg = sa + 192; LAS float* dpart = sa + 256;
    const float* bcum = (const float*)(ws + WS_BCUM); const float* aarr = (const float*)(ws + WS_AARR); const float* amaxa = (const float*)(ws + WS_AMAX);
    const float* blast = (const float*)(ws + WS_BLAST); const float* am63 = (const float*)(ws + WS_AM63);
    float* decay = (float*)(ws + WS_DECAY); float* densum = (float*)(ws + WS_DENSUM); float* eclamp = (float*)(ws + WS_ECLAMP); float* ksum = (float*)(ws + WS_KSUM);
    bf16_t* SW = (bf16_t*)(ws + WS_SW);
    const int lane = C.lane, m = lane & 15, q = lane >> 4, w = C.wid;
    for (int ul = blockIdx.x; ul < 512; ul += gridDim.x) {
        const int bh = ul >> 6, cl = ul & 63, c = seg * 64 + cl, b = bh >> 2, h = bh & 3;
        const int srow0 = b * 4096 + cl * 64, row0 = b * 8192 + c * 64, ug = bh * 128 + c;
        if (w == 0) {
            const float bl0 = blast[bh * 128 + lane], bl1 = blast[bh * 128 + 64 + lane], am0 = am63[bh * 128 + lane], am1 = am63[bh * 128 + 64 + lane];
            float mp = 0.f;
            for (int cc = 0; cc < c; ++cc) { const float bl = __shfl(cc < 64 ? bl0 : bl1, cc & 63), am = __shfl(cc < 64 ? am0 : am1, cc & 63); mp = bl + fmaxf(mp, am); }
            const int t = lane; const float a_t = aarr[(row0 + t) * 4 + h], amx = amaxa[(row0 + t) * 4 + h], bc = bcum[(row0 + t) * 4 + h];
            const float Mt = fmaxf(mp, amx), Mlast = __shfl(Mt, 63);
            sa[t] = a_t; sM[t] = Mt; swi[t] = __expf(mp - Mt); swg[t] = __expf(a_t - Mlast);
            eclamp[(row0 + t) * 4 + h] = __expf(-(bc + Mt));
            if (t == 0) decay[ug] = __expf(mp - Mlast);
        }
        __syncthreads();
        { const int mt = w & 3, ntp = w >> 2;
            f32x4 a0 = {0.f, 0.f, 0.f, 0.f}, a1 = a0;
            const bf16_t* qp = Qs + (size_t)(srow0 + 16 * mt + m) * 2048 + h * 512 + 8 * q;
            const bf16_t* kp0 = Ks + (size_t)(srow0 + 32 * ntp + m) * 2048 + h * 512 + 8 * q; const bf16_t* kp1 = kp0 + (size_t)16 * 2048;
#pragma unroll 4
            for (int kk = 0; kk < 16; ++kk) { const bf16x8 a = *(const bf16x8*)(qp + 32 * kk), b0 = *(const bf16x8*)(kp0 + 32 * kk), b1 = *(const bf16x8*)(kp1 + 32 * kk);
                a0 = __builtin_amdgcn_mfma_f32_16x16x32_bf16(a, b0, a0, 0, 0, 0); a1 = __builtin_amdgcn_mfma_f32_16x16x32_bf16(a, b1, a1, 0, 0, 0); }
            float rs[4];
#pragma unroll
            for (int j = 0; j < 4; ++j) { const int t = 16 * mt + 4 * q + j, s0 = 32 * ntp + m, s1 = s0 + 16; const float Mt = sM[t];
                const float v0 = (s0 <= t) ? a0[j] * __expf(sa[s0] - Mt) : 0.f, v1 = (s1 <= t) ? a1[j] * __expf(sa[s1] - Mt) : 0.f;
                SW[(size_t)ul * 4096 + t * 64 + s0] = (bf16_t)(cvtpk(v0, 0.f) & 0xffffu); SW[(size_t)ul * 4096 + t * 64 + s1] = (bf16_t)(cvtpk(v1, 0.f) & 0xffffu);
                float r = v0 + v1; r += __shfl_xor(r, 1); r += __shfl_xor(r, 2); r += __shfl_xor(r, 4); r += __shfl_xor(r, 8); rs[j] = r; }
            if (m == 0) {
#pragma unroll
                for (int j = 0; j < 4; ++j) dpart[ntp * 64 + 16 * mt + 4 * q + j] = rs[j]; }
        }
        { const int dk = C.tid; float ks = 0.f; const bf16_t* kp = Ks + (size_t)srow0 * 2048 + h * 512 + dk;
#pragma unroll 8
            for (int s = 0; s < 64; ++s) ks += swg[s] * bf2f(kp[(size_t)s * 2048]);
            ksum[(size_t)ug * 512 + dk] = ks; }
        __syncthreads();
        if (C.tid < 64) densum[(row0 + C.tid) * 4 + h] = dpart[C.tid] + dpart[64 + C.tid];
#pragma unroll
        for (int i = 0; i < 8; ++i) { const int id = C.tid + 512 * i, r = id >> 6, ch = id & 63;
            u32x4* qp = (u32x4*)(Qs + (size_t)(srow0 + r) * 2048 + h * 512 + ch * 8); u32x4* kp = (u32x4*)(Ks + (size_t)(srow0 + r) * 2048 + h * 512 + ch * 8);
            u32x4 qv = *qp, kv = *kp; const float fq_ = swi[r], fk_ = swg[r];
#pragma unroll
            for (int e = 0; e < 4; ++e) { qv[e] = cvtpk(bflo(qv[e]) * fq_, bfhi(qv[e]) * fq_); kv[e] = cvtpk(bflo(kv[e]) * fk_, bfhi(kv[e]) * fk_); }
            *qp = qv; *kp = kv; }
        __syncthreads();
    }
}

__device__ __forceinline__ void phase_pb(const Ctx& C0, int seg, const bf16_t* Qs, const bf16_t* Ks, bf16_t* V, unsigned char* ws) {
    const Ctx C = relaunder(C0);
    const float* ksum = (const float*)(ws + WS_KSUM); const float* decay = (const float*)(ws + WS_DECAY); const float* densum = (const float*)(ws + WS_DENSUM);
    const float* eclamp = (const float*)(ws + WS_ECLAMP); float* den = (float*)(ws + WS_DEN); float* Cst = (float*)(ws + WS_CST); float* nst = (float*)(ws + WS_NST);
    const bf16_t* SW = (const bf16_t*)(ws + WS_SW);
    const int lane = C.lane, m = lane & 15, q = lane >> 4, w = C.wid, tid = C.tid;
    LAS unsigned char* kt = C.lds + w * 9216;
    LAS unsigned char* vs = C.lds + 73728;
    LAS float* red = (LAS float*)(C.lds + 75776);
    LAS float* redS = (LAS float*)(C.lds + 108544);
    LAS float* redq = (LAS float*)(C.lds + 116736);
    for (int wg = blockIdx.x; wg < 256; wg += gridDim.x) {
        const int bh = wg >> 5, sl = wg & 31, b = bh >> 2, h = bh & 3;
        f32x4 T[2][2]; float n8[2][8];
#pragma unroll
        for (int ks = 0; ks < 2; ++ks) {
#pragma unroll
            for (int hf = 0; hf < 2; ++hf)
#pragma unroll
                for (int j = 0; j < 4; ++j) { const int dk = 64 * w + 32 * ks + 8 * q + 4 * hf + j; T[ks][hf][j] = seg == 0 ? 0.f : Cst[((size_t)bh * 512 + dk) * 512 + 16 * sl + m]; }
#pragma unroll
            for (int jj = 0; jj < 8; ++jj) n8[ks][jj] = seg == 0 ? 0.f : nst[bh * 512 + 64 * w + 32 * ks + 8 * q + jj];
        }
        u32x4 kr[8]; bf16x8 qa[4][2]; u32x4 vr = {0, 0, 0, 0}; f32x4 ksv[2][2];
        const unsigned voffK = (unsigned)(((lane >> 3) * 2048 + (lane & 7) * 8) * 2), voffQ = (unsigned)((m * 2048 + 8 * q) * 2), voffV = (unsigned)(((tid >> 1) * 2048 + 8 * (tid & 1)) * 2), voffS = (unsigned)(8 * q * 4);
#define PB_ISSUE(cl_) do { const int srow0_ = b * 4096 + (cl_) * 64, row0_ = b * 8192 + (seg * 64 + (cl_)) * 64, ug_ = bh * 128 + seg * 64 + (cl_); \
            const char* kb_ = (const char*)Ks + ((size_t)srow0_ * 2048 + h * 512 + 64 * w) * 2; \
            _Pragma("unroll") for (int i = 0; i < 8; ++i) kr[i] = *(const u32x4*)(kb_ + (size_t)i * 32768 + voffK); \
            const char* vb_ = (const char*)V + ((size_t)row0_ * 2048 + h * 512 + 16 * sl) * 2; \
            if (tid < 128) vr = *(const u32x4*)(vb_ + voffV); \
            const char* sb_ = (const char*)ksum + ((size_t)ug_ * 512 + 64 * w) * 4; \
            _Pragma("unroll") for (int ks = 0; ks < 2; ++ks) { ksv[ks][0] = *(const f32x4*)(sb_ + ks * 128 + voffS); ksv[ks][1] = *(const f32x4*)(sb_ + ks * 128 + 16 + voffS); } } while (0)
#define PB_ISSUE_Q(cl_) do { const int srow0_ = b * 4096 + (cl_) * 64; const char* qb_ = (const char*)Qs + ((size_t)srow0_ * 2048 + h * 512 + 64 * w) * 2; \
            _Pragma("unroll") for (int mt = 0; mt < 4; ++mt) _Pragma("unroll") for (int ks = 0; ks < 2; ++ks) qa[mt][ks] = *(const bf16x8*)(qb_ + (size_t)mt * 65536 + ks * 64 + voffQ); } while (0)
        PB_ISSUE(0); PB_ISSUE_Q(0);
        for (int cl = 0; cl < 64; ++cl) {
            const int c = seg * 64 + cl, row0 = b * 8192 + c * 64, ul = bh * 64 + cl, ug = bh * 128 + c;
#pragma unroll
            for (int i = 0; i < 8; ++i) *(LAS u32x4*)(kt + ((lane >> 3) + 8 * i) * 144 + (lane & 7) * 16) = kr[i];
            if (tid < 128) *(LAS u32x4*)(vs + (tid >> 1) * 32 + (tid & 1) * 16) = vr;
            f32x4 ksc[2][2];
#pragma unroll
            for (int ks = 0; ks < 2; ++ks) { ksc[ks][0] = ksv[ks][0]; ksc[ks][1] = ksv[ks][1]; }
            const float dcy = decay[ug];
            const bf16x8 swa = *(const bf16x8*)(SW + (size_t)ul * 4096 + (16 * (w & 3) + m) * 64 + 32 * (w >> 2) + 8 * q);
            __syncthreads();
            const int cln = cl < 63 ? cl + 1 : cl;
            bf16x8 cb[2];
#pragma unroll
            for (int ks = 0; ks < 2; ++ks) { u32x4 pk; pk.x = cvtpk(T[ks][0][0], T[ks][0][1]); pk.y = cvtpk(T[ks][0][2], T[ks][0][3]); pk.z = cvtpk(T[ks][1][0], T[ks][1][1]); pk.w = cvtpk(T[ks][1][2], T[ks][1][3]); cb[ks] = __builtin_bit_cast(bf16x8, pk); }
            bf16x8 vb[2];
#pragma unroll
            for (int kss = 0; kss < 2; ++kss) { const s16x4 lo = tr16(vs + (32 * kss + 8 * q + (m >> 2)) * 32 + (m & 3) * 8), hi = tr16(vs + (32 * kss + 8 * q + 4 + (m >> 2)) * 32 + (m & 3) * 8);
                vb[kss] = (bf16x8){lo[0], lo[1], lo[2], lo[3], hi[0], hi[1], hi[2], hi[3]}; }
#pragma unroll
            for (int mt = 0; mt < 4; ++mt) {
                f32x4 p = {0.f, 0.f, 0.f, 0.f};
                p = __builtin_amdgcn_mfma_f32_16x16x32_bf16(qa[mt][0], cb[0], p, 0, 0, 0); p = __builtin_amdgcn_mfma_f32_16x16x32_bf16(qa[mt][1], cb[1], p, 0, 0, 0);
#pragma unroll
                for (int j = 0; j < 4; ++j) red[(w * 64 + 16 * mt + 4 * q + j) * 16 + m] = p[j];
                float d = 0.f;
#pragma unroll
                for (int ks = 0; ks < 2; ++ks)
#pragma unroll
                    for (int jj = 0; jj < 8; ++jj) d += bf2f((unsigned short)qa[mt][ks][jj]) * n8[ks][jj];
                d += __shfl_xor(d, 16); d += __shfl_xor(d, 32);
                if (q == 0) redq[w * 64 + 16 * mt + m] = d;
            }
            PB_ISSUE(cln); PB_ISSUE_Q(cln);
            { f32x4 sv = {0.f, 0.f, 0.f, 0.f}; const int kss = w >> 2;
                sv = __builtin_amdgcn_mfma_f32_16x16x32_bf16(swa, kss ? vb[1] : vb[0], sv, 0, 0, 0);
#pragma unroll
                for (int j = 0; j < 4; ++j) redS[(kss * 64 + 16 * (w & 3) + 4 * q + j) * 16 + m] = sv[j]; }
#pragma unroll
            for (int ks = 0; ks < 2; ++ks) {
#pragma unroll
                for (int hf = 0; hf < 2; ++hf) { f32x4 t = T[ks][hf] * dcy;
#pragma unroll
                    for (int kss = 0; kss < 2; ++kss) { const LAS unsigned char* ap = kt + (32 * kss + 8 * q + (m >> 2)) * 144 + (32 * ks + 8 * (m & 3) + 4 * hf) * 2;
                        const s16x4 lo = tr16(ap), hi = tr16(ap + 4 * 144);
                        const bf16x8 ka = (bf16x8){lo[0], lo[1], lo[2], lo[3], hi[0], hi[1], hi[2], hi[3]};
                        t = __builtin_amdgcn_mfma_f32_16x16x32_bf16(ka, vb[kss], t, 0, 0, 0); }
                    T[ks][hf] = t; }
#pragma unroll
                for (int jj = 0; jj < 8; ++jj) n8[ks][jj] = dcy * n8[ks][jj] + ksc[ks][jj >> 2][jj & 3];
            }
            __syncthreads();
            { const int t = tid >> 3, pr = tid & 7; float s0 = redS[t * 16 + 2 * pr] + redS[(64 + t) * 16 + 2 * pr], s1 = redS[t * 16 + 2 * pr + 1] + redS[(64 + t) * 16 + 2 * pr + 1];
#pragma unroll
                for (int ww = 0; ww < 8; ++ww) { s0 += red[(ww * 64 + t) * 16 + 2 * pr]; s1 += red[(ww * 64 + t) * 16 + 2 * pr + 1]; }
                *(unsigned*)(V + (size_t)(row0 + t) * 2048 + h * 512 + 16 * sl + 2 * pr) = cvtpk(s0, s1);
                if (sl == 0 && pr == 0) { float qn = 0.f;
#pragma unroll
                    for (int ww = 0; ww < 8; ++ww) qn += redq[ww * 64 + t];
                    const float dn = densum[(row0 + t) * 4 + h] + qn; den[(row0 + t) * 4 + h] = fmaxf(fabsf(dn), eclamp[(row0 + t) * 4 + h]); } }
        }
#undef PB_ISSUE
#undef PB_ISSUE_Q
        if (seg == 0) {
#pragma unroll
            for (int ks = 0; ks < 2; ++ks) {
#pragma unroll
                for (int hf = 0; hf < 2; ++hf)
#pragma unroll
                    for (int j = 0; j < 4; ++j) { const int dk = 64 * w + 32 * ks + 8 * q + 4 * hf + j; Cst[((size_t)bh * 512 + dk) * 512 + 16 * sl + m] = T[ks][hf][j]; }
                if (sl == 0 && m == 0) {
#pragma unroll
                    for (int jj = 0; jj < 8; ++jj) nst[bh * 512 + 64 * w + 32 * ks + 8 * q + jj] = n8[ks][jj]; }
            }
        }
        __syncthreads();
    }
}

__device__ __forceinline__ void phase_stats(const Ctx& C0, const bf16_t* NUM, unsigned char* ws) {
    const Ctx C = relaunder(C0);
    const float* den = (const float*)(ws + WS_DEN); float* gn = (float*)(ws + WS_GNSTAT);
    for (int it = C.gw; it < M * 4; it += C.NGW) { const int row = it >> 2, h = it & 3;
        const u32x4 raw = *(const u32x4*)(NUM + (size_t)row * 2048 + h * 512 + 8 * C.lane);
        float v[8]; float s = 0.f;
#pragma unroll
        for (int e = 0; e < 4; ++e) { v[2 * e] = bflo(raw[e]); v[2 * e + 1] = bfhi(raw[e]); s += v[2 * e] + v[2 * e + 1]; }
        const float mean = wave_sum(s) * (1.f / 512.f); float q2 = 0.f;
#pragma unroll
        for (int e = 0; e < 8; ++e) { const float d = v[e] - mean; q2 += d * d; }
        const float var = wave_sum(q2) * (1.f / 512.f), dn = den[it];
        if (C.lane == 0) { gn[(size_t)it * 2] = mean; gn[(size_t)it * 2 + 1] = 1.0f / sqrtf(var + 1e-6f * dn * dn); }
    }
}

__device__ __forceinline__ void phase_attn(const Ctx& C0, const bf16_t* QB, const bf16_t* KB, const bf16_t* VT, const bf16_t* GB, bf16_t* OG, const float* relb) {
    const Ctx C = relaunder(C0);
    LAS float* sb = (LAS float*)C.lds;
    for (int i = C.tid; i < 16 * 257; i += 512) sb[i] = relb[i];
    __syncthreads();
    const int lane = C.lane, n = lane & 15, q = lane >> 4;
    for (int it = C.gw; it < 16384; it += C.NGW) {
        const int qb = it & 3, h = (it >> 2) & 15, c = (it >> 6) & 127, b = it >> 13;
        const int qrow0 = b * 8192 + 64 * c + 16 * qb;
        bf16x8 qf[2];
#pragma unroll
        for (int ks = 0; ks < 2; ++ks) qf[ks] = *(const bf16x8*)(QB + (size_t)(qrow0 + n) * 1024 + h * 64 + 32 * ks + 8 * q);
        f32x4 o[4];
#pragma unroll
        for (int mt = 0; mt < 4; ++mt) o[mt] = (f32x4){0.f, 0.f, 0.f, 0.f};
        float mrun = -1e30f, lrun = 0.f;
        const int st0 = c < 8 ? (16 - 2 * c) : 0;
        for (int st = st0; st < 18; ++st) {
            const int kpos0 = 64 * c - 512 + 32 * st;
            f32x4 s0 = {0.f, 0.f, 0.f, 0.f}, s1 = s0;
            const bf16_t* kp = KB + (size_t)(b * 8192 + kpos0 + 8 * (n >> 2) + (n & 3)) * 1024 + h * 64 + 8 * q;
#pragma unroll
            for (int ks = 0; ks < 2; ++ks) { const bf16x8 k0 = *(const bf16x8*)(kp + 32 * ks), k1 = *(const bf16x8*)(kp + (size_t)4 * 1024 + 32 * ks);
                s0 = __builtin_amdgcn_mfma_f32_16x16x32_bf16(k0, qf[ks], s0, 0, 0, 0); s1 = __builtin_amdgcn_mfma_f32_16x16x32_bf16(k1, qf[ks], s1, 0, 0, 0); }
            bf16x8 va[4];
#pragma unroll
            for (int mt = 0; mt < 4; ++mt) va[mt] = *(const bf16x8*)(VT + (size_t)(h * 64 + 16 * mt + n) * 16384 + b * 8192 + kpos0 + 8 * q);
            const int dq0 = (64 * c + 16 * qb + n) - (kpos0 + 8 * q);
            float sc[8]; float mx = -1e30f;
#pragma unroll
            for (int jj = 0; jj < 8; ++jj) { int d = dq0 - jj; d = d < -128 ? -128 : (d > 128 ? 128 : d); sc[jj] = (jj < 4 ? s0[jj & 3] : s1[jj & 3]) + sb[h * 257 + d + 128]; mx = fmaxf(mx, sc[jj]); }
            mx = fmaxf(mx, __shfl_xor(mx, 16)); mx = fmaxf(mx, __shfl_xor(mx, 32));
            const float mnew = fmaxf(mrun, mx), scale = __expf(mrun - mnew);
            float ps = 0.f;
#pragma unroll
            for (int jj = 0; jj < 8; ++jj) { sc[jj] = __expf(sc[jj] - mnew); ps += sc[jj]; }
            lrun = lrun * scale + ps; mrun = mnew;
            u32x4 pk; pk.x = cvtpk(sc[0], sc[1]); pk.y = cvtpk(sc[2], sc[3]); pk.z = cvtpk(sc[4], sc[5]); pk.w = cvtpk(sc[6], sc[7]);
            const bf16x8 pb = __builtin_bit_cast(bf16x8, pk);
#pragma unroll
            for (int mt = 0; mt < 4; ++mt) { o[mt] = o[mt] * scale; o[mt] = __builtin_amdgcn_mfma_f32_16x16x32_bf16(va[mt], pb, o[mt], 0, 0, 0); }
        }
        float lt = lrun + __shfl_xor(lrun, 16); lt += __shfl_xor(lt, 32);
        const float inv = 1.0f / lt;
#pragma unroll
        for (int mt = 0; mt < 4; ++mt) { const size_t off = (size_t)(qrow0 + n) * 1024 + h * 64 + 16 * mt + 4 * q;
            const u32x2 g = *(const u32x2*)(GB + off); const float gv[4] = {bflo(g.x), bfhi(g.x), bflo(g.y), bfhi(g.y)};
            float r[4];
#pragma unroll
            for (int e = 0; e < 4; ++e) r[e] = o[mt][e] * inv * (gv[e] * sigmoidf_(gv[e]));
            u32x2 wv; wv.x = cvtpk(r[0], r[1]); wv.y = cvtpk(r[2], r[3]); *(u32x2*)(OG + off) = wv; }
    }
    __syncthreads();
}

struct Params { const float* in[19]; float* out; unsigned char* ws; };
typedef const __attribute__((address_space(4))) Params* KP;
__device__ __forceinline__ KP kargs() { KP q = (KP)__builtin_amdgcn_kernarg_segment_ptr(); asm volatile("" : "+s"(q)); return q; }

__global__ void __launch_bounds__(512) fwd_megakernel(Params p_unused) {
    extern __shared__ __attribute__((aligned(16))) unsigned char lds_raw[];
    cg::grid_group grid = cg::this_grid();
    Ctx C; C.lds = (LAS unsigned char*)lds_raw; C.tid = threadIdx.x; C.lane = C.tid & 63; C.wid = __builtin_amdgcn_readfirstlane(C.tid >> 6);
    C.gw = blockIdx.x * 8 + C.wid; C.NGW = gridDim.x * 8;
    const int G = gridDim.x, cidx = blockIdx.x;
#define WSP (kargs()->ws)
#define INP(i) (kargs()->in[i])
#define XP (kargs()->out)
#define XNP ((bf16_t*)(WSP + WS_XN))
#define B0P ((bf16_t*)(WSP + WS_BUF0))
#define B1P ((bf16_t*)(WSP + WS_BUF1))
#define B2P ((bf16_t*)(WSP + WS_BUF2))
    rows_ln(C, INP(0), XP, XNP, nullptr, nullptr);
    { AW w{INP(1), INP(5), INP(6), INP(7), INP(10)}; convert_a_weights(C, w, WSP); }
    grid.sync();

    for (int l = 0; l < 2; ++l) {
        { unsigned char* ws = WSP; Sched S; S.init(64, 8, G, cidx, ws + WS_XN, ws + WS_WXM, 1024, 1024); EpiPlain E{(bf16_t*)(ws + WS_BUF0), 2048}; pg8::gemm_phase(C.lds, S, 1024, 1024, 1024, E); }
        grid.sync();
        phase_a2(C, XP, INP(1) + (size_t)l * 1024 * 6152, INP(2) + l * 8, INP(3) + (size_t)l * 4 * 2048, INP(4) + l * 2048, B0P, B1P, WSP);
        { unsigned char* ws = WSP; Sched S; S.init(64, 8, G, cidx, ws + WS_BUF0, ws + WS_WV, 2048, 512); S.grp_shift = 1; S.a_grp_bytes = 1024; EpiPlain E{(bf16_t*)(ws + WS_BUF2), 2048}; pg8::gemm_phase(C.lds, S, 512, 2048, 512, E); }
        grid.sync();
        for (int seg = 0; seg < 2; ++seg) {
            { unsigned char* ws = WSP; Sched S; S.init(32, 16, G, cidx, ws + WS_BUF1, ws + WS_WQK, 2048, 512); S.seg = seg; S.grp_shift = 2; S.a_grp_bytes = 1024; EpiQK E{(bf16_t*)(ws + WS_BUF0), (size_t)8192 * 2048, seg}; pg8::gemm_phase(C.lds, S, 512, 2048, 512, E); }
            grid.sync();
            phase_pa(C, seg, B0P, B0P + (size_t)8192 * 2048, WSP);
            grid.sync();
            phase_pb(C, seg, B0P, B0P + (size_t)8192 * 2048, B2P, WSP);
            grid.sync();
        }
        phase_stats(C, B2P, WSP);
        convert_zo_weights(C, INP(1) + (size_t)l * 1024 * 6152, WSP);
        grid.sync();
        { unsigned char* ws = WSP; Sched S; S.init(64, 16, G, cidx, ws + WS_XN, ws + WS_WZO, 1024, 1024);
          EpiGate E{(bf16_t*)(ws + WS_BUF2), (bf16_t*)(ws + WS_BUF1), (const float*)(ws + WS_GNSTAT), INP(8) + l * 2048, INP(9) + l * 2048, (bf16_t*)(ws + WS_BUF0)};
          pg8::gemm_phase(C.lds, S, 1024, 1024, 1024, E); }
        grid.sync();
        { unsigned char* ws = WSP; Sched S; S.init(64, 4, G, cidx, ws + WS_BUF0, ws + WS_WOUT, 2048, 2048); EpiResid E{XP}; pg8::gemm_phase(C.lds, S, 2048, 2048, 2048, E); }
        grid.sync();
        rows_ln(C, XP, XP, XNP, INP(11) + l * 1024, INP(12) + l * 1024);
        if (l == 0) { AW w{INP(1) + (size_t)1024 * 6152, INP(5) + (size_t)4 * 262144, INP(6) + (size_t)4 * 262144, INP(7) + (size_t)4 * 262144, INP(10) + (size_t)2048 * 1024}; convert_a_weights(C, w, WSP); }
        else convert_b_weights(C, INP(13), INP(14), INP(16), WSP);
        grid.sync();
    }
    for (int l = 0; l < 2; ++l) {
        { unsigned char* ws = WSP; Sched S; S.init(64, l == 0 ? 12 : 8, G, cidx, ws + WS_XN, ws + (l == 0 ? WS_BW0 : WS_BW1), 1024, 1024); EpiSplit3 E{(bf16_t*)(ws + WS_QB), (size_t)16 * 1024 * 1024}; pg8::gemm_phase(C.lds, S, 1024, 1024, 1024, E); }
        if (l == 0) { unsigned char* ws = WSP; Sched S; S.init(4, 64, G, cidx, ws + WS_BVW, ws + WS_XN, 1024, 1024); EpiPlain E{(bf16_t*)(ws + WS_VT), 16384}; pg8::gemm_phase(C.lds, S, 1024, 1024, 1024, E); }
        grid.sync();
        { unsigned char* ws = WSP; phase_attn(C, (const bf16_t*)(ws + WS_QB), (const bf16_t*)(ws + WS_KB), (const bf16_t*)(ws + WS_VT), (const bf16_t*)(ws + WS_GB), (bf16_t*)(ws + WS_OG), INP(15) + (size_t)l * 16 * 257); }
        grid.sync();
        { unsigned char* ws = WSP; Sched S; S.init(64, 4, G, cidx, ws + WS_OG, ws + (l == 0 ? WS_BO0 : WS_BO1), 1024, 1024); EpiResid E{XP}; pg8::gemm_phase(C.lds, S, 1024, 1024, 1024, E); }
        grid.sync();
        rows_ln(C, XP, XP, XNP, INP(17) + l * 1024, INP(18) + l * 1024);
        if (l == 0) grid.sync();
    }
}

extern "C" void kernel_launch(void* const* d_in, const int* in_sizes, int n_in, void* d_out, int out_size, void* d_ws, size_t ws_size, hipStream_t stream) {
    static int grid = 0;
    if (grid == 0) {
        if (n_in != 19 || out_size != M * DM || ws_size < WS_END) { fprintf(stderr, "kernel_launch: unexpected problem (n_in %d out %d ws %zu)\n", n_in, out_size, ws_size); grid = -1; return; }
        int dev = 0, cus = 0, per_cu = 0;
        hipGetDevice(&dev); hipDeviceGetAttribute(&cus, hipDeviceAttributeMultiprocessorCount, dev);
        if (hipFuncSetAttribute((const void*)fwd_megakernel, hipFuncAttributeMaxDynamicSharedMemorySize, LDS_BYTES) != hipSuccess) { fprintf(stderr, "kernel_launch: hipFuncSetAttribute failed\n"); grid = -1; return; }
        hipOccupancyMaxActiveBlocksPerMultiprocessor(&per_cu, (const void*)fwd_megakernel, 512, LDS_BYTES);
        (void)hipGetLastError();
        if (per_cu < 1) per_cu = 1;
        grid = cus * per_cu; if (grid > 256) grid = 256;
        fprintf(stderr, "kernel_launch: grid %d (cus %d per_cu %d)\n", grid, cus, per_cu);
    }
    if (grid < 0) return;
    Params p{};
    for (int i = 0; i < 19; ++i) p.in[i] = (const float*)d_in[i];
    p.out = (float*)d_out; p.ws = (unsigned char*)d_ws;
    void* args[] = {&p};
    hipError_t e = hipLaunchCooperativeKernel((const void*)fwd_megakernel, dim3(grid), dim3(512), args, LDS_BYTES, stream);
    if (e != hipSuccess) fprintf(stderr, "cooperative launch failed: %s (grid %d)\n", hipGetErrorString(e), grid);
}
```

```cpp
#include <hip/hip_runtime.h>
#include <hip/hip_cooperative_groups.h>
#include <cstdint>
#include <cstdio>
namespace cg = cooperative_groups;
#ifndef PROBE_MASK
#define PROBE_MASK 0
#endif

#define LAS __attribute__((address_space(3)))
typedef unsigned short bf16_t;
typedef short bf16x8 __attribute__((ext_vector_type(8)));
typedef short s16x4 __attribute__((ext_vector_type(4)));
typedef float f32x4 __attribute__((ext_vector_type(4)));
typedef unsigned u32x4 __attribute__((ext_vector_type(4)));
typedef unsigned u32x2 __attribute__((ext_vector_type(2)));
typedef float f32x2_t __attribute__((ext_vector_type(2)));
typedef __bf16 bf16x2_t __attribute__((ext_vector_type(2)));

constexpr int M = 16384, DM = 1024, AI = 2048, SEQ = 8192, NCH = 128;
constexpr float ALPHA = 1.681792830507429f;
constexpr size_t MiB = 1u << 20;
constexpr size_t WS_IPRE = 0, WS_LFS = 256 * 1024, WS_BCUM = 512 * 1024, WS_AARR = 768 * 1024, WS_AMAX = 1024 * 1024,
                 WS_DENSUM = 1280 * 1024, WS_ECLAMP = 1536 * 1024, WS_DEN = 1792 * 1024;
constexpr size_t WS_GNSTAT = 2 * MiB, WS_BLAST = 2 * MiB + 512 * 1024, WS_AM63 = WS_BLAST + 4096, WS_DECAY = WS_AM63 + 4096;
constexpr size_t WS_BAR = WS_DECAY + 8192;
constexpr size_t WS_KSUM = 3 * MiB, WS_SW = 5 * MiB, WS_CST = 9 * MiB, WS_NST = 17 * MiB;
constexpr size_t WS_W = 18 * MiB;
constexpr size_t WS_WXM = WS_W, WS_WV = WS_W + 4 * MiB, WS_WQK = WS_W + 6 * MiB, WS_WOUT = WS_W + 10 * MiB;
constexpr size_t WS_WZO = WS_CST;
constexpr size_t WS_XN = 32 * MiB, WS_BUF0 = 64 * MiB, WS_BUF1 = 128 * MiB, WS_BUF2 = 192 * MiB, WS_END = 256 * MiB;
constexpr size_t WS_BW0 = 64 * MiB  , WS_BVW = 70 * MiB  , WS_BO0 = 72 * MiB  , WS_BW1 = 74 * MiB  , WS_BO1 = 78 * MiB  ;
constexpr size_t WS_QB = 80 * MiB, WS_GB = 112 * MiB, WS_KB = 144 * MiB, WS_VT = 176 * MiB, WS_OG = 208 * MiB;

constexpr int LDS_BYTES = 147456;

__device__ __forceinline__ unsigned cvtpk(float lo, float hi) { f32x2_t v = {lo, hi}; bf16x2_t b = __builtin_convertvector(v, bf16x2_t); return __builtin_bit_cast(unsigned, b); }
__device__ __forceinline__ float bflo(unsigned u) { return __uint_as_float(u << 16); }
__device__ __forceinline__ float bfhi(unsigned u) { return __uint_as_float(u & 0xffff0000u); }
__device__ __forceinline__ float bf2f(unsigned short u) { return __uint_as_float(((unsigned)u) << 16); }
__device__ __forceinline__ float wave_sum(float v) {
#pragma unroll
    for (int o = 1; o < 64; o <<= 1) v += __shfl_xor(v, o);
    return v;
}
__device__ __forceinline__ float sigmoidf_(float x) { return 1.0f / (1.0f + __expf(-x)); }
__device__ __forceinline__ s16x4 tr16(const LAS unsigned char* p) { return __builtin_bit_cast(s16x4, __builtin_amdgcn_ds_read_tr16_b64_v4i16((LAS s16x4*)p)); }

namespace pg8 {
constexpr int BM = 256, BK = 64, HALF = 128, HTB = HALF * BK * 2, STAGE_BYTES = 8 * HTB, NXCD = 8, WGM = 8;
__host__ __device__ __forceinline__ int lds_byte(int r, int c) { const int st = (r >> 4) * 2 + (c >> 5), rr = r & 15, cc = c & 31, ob = rr * 64 + cc * 2; return st * 1024 + (ob ^ (((ob >> 9) & 1) << 5)); }
__host__ __device__ __forceinline__ void stage_rc(int b, int& R, int& C) { const int st = b / 1024, sb = b % 1024, swz = sb ^ (((sb >> 9) & 1) << 5); R = (st >> 1) * 16 + swz / 64; C = (st & 1) * 32 + (swz % 64) / 2; }

struct Unit { int pm, pn; const char* a; const char* b; };
struct Sched {
    int nM, nN, nwg, G, c;
    const char* A; const char* B; size_t a_tstep, b_tstep;
    int seg;
    int grp_shift; size_t a_grp_bytes;
    __device__ __forceinline__ void init(int nM_, int nN_, int G_, int c_, const void* A_, const void* B_, int lda, int ldb) {
        nM = nM_; nN = nN_; nwg = nM * nN; G = G_; c = c_; A = (const char*)A_; B = (const char*)B_;
        a_tstep = (size_t)BM * lda * 2; b_tstep = (size_t)BM * ldb * 2; seg = -1; grp_shift = 30; a_grp_bytes = 0;
    }
    __device__ __forceinline__ bool next(int i, Unit& u) const {
        const long L = (long)i * G + c; if (L >= nwg) return false;
        int wgid = (int)L; { const int q = nwg / NXCD, r = nwg % NXCD, xcd = wgid % NXCD, off = wgid / NXCD; wgid = (xcd < r ? xcd * (q + 1) : r * (q + 1) + (xcd - r) * q) + off; }
        const int nig = WGM * nN, gid = wgid / nig, fm = gid * WGM, gsz = (nM - fm) < WGM ? (nM - fm) : WGM;
        int pmv = fm + ((wgid % nig) % gsz); u.pn = (wgid % nig) / gsz;
        u.pm = seg < 0 ? pmv : ((pmv >> 4) * 32 + 16 * seg + (pmv & 15));
        u.a = A + (size_t)u.pm * a_tstep + (size_t)(u.pn >> grp_shift) * a_grp_bytes; u.b = B + (size_t)u.pn * b_tstep; return true;
    }
};

template <class Epi>
__device__ __forceinline__ void gemm_phase(LAS unsigned char* lds, const Sched& S, int K, int lda, int ldb, const Epi& E) {
    int tid_ = threadIdx.x; asm volatile("" : "+v"(tid_));
    const int tid = tid_, wid = __builtin_amdgcn_readfirstlane(tid >> 6), lane = tid & 63, wr = wid >> 2, wc = wid & 3, fr = lane & 15, fq = lane >> 4;
    const int nt = K / BK;
    unsigned voffA[2], voffB[2];
#pragma unroll
    for (int i = 0; i < 2; ++i) { int R, C; stage_rc(tid * 16 + i * 8192, R, C); voffA[i] = (unsigned)(R * lda + C) * 2u; voffB[i] = (unsigned)(R * ldb + C) * 2u; }
    const size_t kstep = (size_t)(BK * 2);
    const size_t hstepA = (size_t)HALF * lda * 2, hstepB = (size_t)HALF * ldb * 2;
    const unsigned ldsw = (unsigned)wid * 1024u;
    const int aoff = lds_byte(wr * 64 + fr, fq * 8), boff = lds_byte(wc * 32 + fr, fq * 8);
#define PG8_SA(b, h) (((b) * 2 + (h)) * HTB)
#define PG8_SB(b, h) ((4 + (b) * 2 + (h)) * HTB)
#define PG8_STAGE(bufoff, gbase, voff) do { _Pragma("unroll") for (int _i = 0; _i < 2; ++_i) \
        __builtin_amdgcn_global_load_lds((const unsigned*)((const char*)(gbase) + (voff)[_i]), (LAS unsigned*)(lds + (bufoff) + ldsw + _i * 8192), 16, 0, 0); } while (0)
#define PG8_LDA(dst, b, h) do { _Pragma("unroll") for (int m = 0; m < 4; ++m) _Pragma("unroll") for (int k = 0; k < 2; ++k) dst[m][k] = *(const LAS bf16x8*)(lds + PG8_SA(b, h) + aoff + m * 2048 + k * 1024); } while (0)
#define PG8_LDB(dst, b, h) do { _Pragma("unroll") for (int n = 0; n < 2; ++n) _Pragma("unroll") for (int k = 0; k < 2; ++k) dst[n][k] = *(const LAS bf16x8*)(lds + PG8_SB(b, h) + boff + n * 2048 + k * 1024); } while (0)
#define PG8_MMA(ai, bj, At, Bt) do { __builtin_amdgcn_s_setprio(1); _Pragma("unroll") for (int m = 0; m < 4; ++m) _Pragma("unroll") for (int n = 0; n < 2; ++n) _Pragma("unroll") for (int k = 0; k < 2; ++k) \
        acc[ai][bj][m][n] = __builtin_amdgcn_mfma_f32_16x16x32_bf16(Bt[n][k], At[m][k], acc[ai][bj][m][n], 0, 0, 0); __builtin_amdgcn_s_setprio(0); } while (0)
#define PG8_WAIT_V(n) asm volatile("s_waitcnt vmcnt(" #n ")" ::: "memory")
#define PG8_WAIT_L(n) asm volatile("s_waitcnt lgkmcnt(" #n ")" ::: "memory")
#define PG8_BAR __builtin_amdgcn_s_barrier()
#define PG8_SCHED __builtin_amdgcn_sched_barrier(0)
    Unit cur, nxt; int ui = 0;
    if (!S.next(0, cur)) return;
    f32x4 acc[2][2][4][2];
#pragma unroll
    for (int a = 0; a < 2; ++a)
#pragma unroll
        for (int b = 0; b < 2; ++b)
#pragma unroll
            for (int m = 0; m < 4; ++m)
#pragma unroll
                for (int n = 0; n < 2; ++n) acc[a][b][m][n] = (f32x4){0.f, 0.f, 0.f, 0.f};
    bf16x8 At[4][2], B0[2][2], B1[2][2];
    const char* cA = cur.a; const char* cB = cur.b;
    PG8_STAGE(PG8_SB(0, 0), cB, voffB); PG8_STAGE(PG8_SB(0, 1), cB + hstepB, voffB); PG8_STAGE(PG8_SA(0, 0), cA, voffA); PG8_STAGE(PG8_SA(0, 1), cA + hstepA, voffA);
    if (wr == 1) PG8_BAR;
    PG8_WAIT_V(2); PG8_BAR;
    PG8_STAGE(PG8_SB(1, 0), cB + kstep, voffB); PG8_STAGE(PG8_SA(1, 0), cA + kstep, voffA); PG8_STAGE(PG8_SB(1, 1), cB + hstepB + kstep, voffB);
    PG8_WAIT_V(6); PG8_BAR;
    for (;;) {
        const bool has_next = S.next(ui + 1, nxt);
        const char* nA = has_next ? nxt.a : cA; const char* nB = has_next ? nxt.b : cB;
        for (int t = 0; t < nt; t += 2) {
            const bool last = (t == nt - 2);
            const char* a1 = cA + (size_t)(t + 1) * kstep;
            const char* a2 = last ? nA : cA + (size_t)(t + 2) * kstep; const char* b2 = last ? nB : cB + (size_t)(t + 2) * kstep;
            const char* a3 = a2 + kstep; const char* b3 = b2 + kstep;
            PG8_LDB(B0, 0, 0); PG8_LDB(B1, 0, 1); PG8_SCHED; PG8_LDA(At, 0, 0); PG8_STAGE(PG8_SA(1, 1), a1 + hstepA, voffA);
            PG8_WAIT_V(8); PG8_WAIT_L(0); PG8_BAR; PG8_MMA(0, 0, At, B0); PG8_MMA(0, 1, At, B1); PG8_BAR; PG8_SCHED;
            PG8_LDA(At, 0, 1); PG8_STAGE(PG8_SB(0, 0), b2, voffB); PG8_STAGE(PG8_SB(0, 1), b2 + hstepB, voffB); PG8_STAGE(PG8_SA(0, 0), a2, voffA);
            PG8_WAIT_V(8); PG8_WAIT_L(0); PG8_BAR; PG8_MMA(1, 0, At, B0); PG8_MMA(1, 1, At, B1); PG8_BAR; PG8_SCHED;
            PG8_LDB(B0, 1, 0); PG8_LDB(B1, 1, 1); PG8_SCHED; PG8_LDA(At, 1, 0); PG8_STAGE(PG8_SA(0, 1), a2 + hstepA, voffA);
            PG8_WAIT_V(8); PG8_WAIT_L(0); PG8_BAR; PG8_MMA(0, 0, At, B0); PG8_MMA(0, 1, At, B1); PG8_BAR; PG8_SCHED;
            PG8_LDA(At, 1, 1); PG8_STAGE(PG8_SB(1, 0), b3, voffB); PG8_STAGE(PG8_SB(1, 1), b3 + hstepB, voffB); PG8_STAGE(PG8_SA(1, 0), a3, voffA);
            PG8_WAIT_V(8); PG8_WAIT_L(0); PG8_BAR; PG8_MMA(1, 0, At, B0); PG8_MMA(1, 1, At, B1); PG8_BAR; PG8_SCHED;
        }
        if (wr == 0) PG8_BAR;
        E(acc, cur, wr, wc, fr, fq);
        if (!has_next) break;
#pragma unroll
        for (int a = 0; a < 2; ++a)
#pragma unroll
            for (int b = 0; b < 2; ++b)
#pragma unroll
                for (int m = 0; m < 4; ++m)
#pragma unroll
                    for (int n = 0; n < 2; ++n) acc[a][b][m][n] = (f32x4){0.f, 0.f, 0.f, 0.f};
        cur = nxt; cA = nA; cB = nB; ++ui;
        if (wr == 1) PG8_BAR;
    }
    PG8_WAIT_V(0);
    PG8_BAR;
#undef PG8_SA
#undef PG8_SB
#undef PG8_STAGE
#undef PG8_LDA
#undef PG8_LDB
#undef PG8_MMA
#undef PG8_WAIT_V
#undef PG8_WAIT_L
#undef PG8_BAR
#undef PG8_SCHED
}
}
using pg8::Unit; using pg8::Sched;

#define EPI_LOOP_BEGIN \
    _Pragma("unroll") for (int ai = 0; ai < 2; ++ai) _Pragma("unroll") for (int m = 0; m < 4; ++m) { const int row = u.pm * 256 + ai * 128 + wr * 64 + m * 16 + fr; \
    _Pragma("unroll") for (int bj = 0; bj < 2; ++bj) _Pragma("unroll") for (int n = 0; n < 2; ++n) { const int col = u.pn * 256 + bj * 128 + wc * 32 + n * 16 + fq * 4; const f32x4 v = acc[ai][bj][m][n];
#define EPI_LOOP_END } }

struct EpiPlain { bf16_t* O; size_t ldc;
    __device__ __forceinline__ void operator()(const f32x4 (&acc)[2][2][4][2], const Unit& u, int wr, int wc, int fr, int fq) const {
        EPI_LOOP_BEGIN
            u32x2 w; w.x = cvtpk(v[0], v[1]); w.y = cvtpk(v[2], v[3]); *(u32x2*)(O + (size_t)row * ldc + col) = w;
        EPI_LOOP_END
    } };
struct EpiQK { bf16_t* Q; size_t kstride; int seg;
    __device__ __forceinline__ void operator()(const f32x4 (&acc)[2][2][4][2], const Unit& u, int wr, int wc, int fr, int fq) const {
        EPI_LOOP_BEGIN
            const int orow = (row >> 13) * 4096 + ((row & 8191) - 4096 * seg); const int head = col >> 10, e = col & 1023;
            bf16_t* dst = Q + (size_t)(e >> 9) * kstride + (size_t)orow * 2048 + head * 512 + (e & 511);
            u32x2 w; w.x = cvtpk(v[0], v[1]); w.y = cvtpk(v[2], v[3]); *(u32x2*)dst = w;
        EPI_LOOP_END
    } };
struct EpiSplit3 { bf16_t* O0; size_t stride;
    __device__ __forceinline__ void operator()(const f32x4 (&acc)[2][2][4][2], const Unit& u, int wr, int wc, int fr, int fq) const {
        EPI_LOOP_BEGIN
            const int t = col >> 10; bf16_t* dst = O0 + (size_t)t * stride + (size_t)row * 1024 + (col & 1023);
            u32x2 w; w.x = cvtpk(v[0], v[1]); w.y = cvtpk(v[2], v[3]); *(u32x2*)dst = w;
        EPI_LOOP_END
    } };
struct EpiResid { float* X;
    __device__ __forceinline__ void operator()(const f32x4 (&acc)[2][2][4][2], const Unit& u, int wr, int wc, int fr, int fq) const {
        EPI_LOOP_BEGIN
            f32x4* p = (f32x4*)(X + (size_t)row * 1024 + col); const f32x4 x = *p; *p = x * ALPHA + v;
        EPI_LOOP_END
    } };
struct EpiGate { const bf16_t* NUM; const bf16_t* XC; const float* gnstat; const float* gnw; const float* skip; bf16_t* HG;
    __device__ __forceinline__ void operator()(const f32x4 (&acc)[2][2][4][2], const Unit& u, int wr, int wc, int fr, int fq) const {
#pragma unroll
        for (int ai = 0; ai < 2; ++ai)
#pragma unroll
            for (int m = 0; m < 4; ++m) { const int row = u.pm * 256 + ai * 128 + wr * 64 + m * 16 + fr;
#pragma unroll
                for (int n = 0; n < 2; ++n) { const int c = u.pn * 128 + wc * 32 + n * 16 + fq * 4; const int head = c >> 9;
                    const f32x4 z = acc[ai][0][m][n], o = acc[ai][1][m][n];
                    const u32x2 nm = *(const u32x2*)(NUM + (size_t)row * 2048 + c), xc = *(const u32x2*)(XC + (size_t)row * 2048 + c);
                    const float mean = gnstat[((size_t)row * 4 + head) * 2], rstd = gnstat[((size_t)row * 4 + head) * 2 + 1];
                    const f32x4 gw = *(const f32x4*)(gnw + c), sk = *(const f32x4*)(skip + c);
                    const float nv[4] = {bflo(nm.x), bfhi(nm.x), bflo(nm.y), bfhi(nm.y)}, xv[4] = {bflo(xc.x), bfhi(xc.x), bflo(xc.y), bfhi(xc.y)};
                    float r[4];
#pragma unroll
                    for (int e = 0; e < 4; ++e) { const float hn = (nv[e] - mean) * rstd * gw[e]; r[e] = (sigmoidf_(o[e]) * hn + sk[e] * xv[e]) * (z[e] * sigmoidf_(z[e])); }
                    u32x2 w; w.x = cvtpk(r[0], r[1]); w.y = cvtpk(r[2], r[3]); *(u32x2*)(HG + (size_t)row * 2048 + c) = w; } }
    } };

struct Ctx { int tid, lane, wid, gw, NGW; LAS unsigned char* lds; };
__device__ __forceinline__ Ctx relaunder(const Ctx& C0) { Ctx C = C0; int t = threadIdx.x; asm volatile("" : "+v"(t)); C.tid = t; C.lane = t & 63; C.wid = __builtin_amdgcn_readfirstlane(t >> 6); C.gw = blockIdx.x * 8 + C.wid; return C; }

__device__ __forceinline__ void tr_block(const float* W, int ldw, int scol, bf16_t* WT, int Kd, int drow, int k0, float scale, LAS float* scr, int lane) {
#pragma unroll 8
    for (int i = 0; i < 32; ++i) { const int kk = 2 * i + (lane >> 5); scr[kk * 33 + (lane & 31)] = W[(size_t)(k0 + kk) * ldw + scol + (lane & 31)] * scale; }
    asm volatile("s_waitcnt lgkmcnt(0)" ::: "memory");
    const int c = lane & 7;
#pragma unroll
    for (int j = 0; j < 4; ++j) { const int n = (lane >> 3) + 8 * j; const LAS float* s = scr + (8 * c) * 33 + n;
        u32x4 o; o.x = cvtpk(s[0 * 33], s[1 * 33]); o.y = cvtpk(s[2 * 33], s[3 * 33]); o.z = cvtpk(s[4 * 33], s[5 * 33]); o.w = cvtpk(s[6 * 33], s[7 * 33]);
        *(u32x4*)(WT + (size_t)(drow + n) * Kd + k0 + 8 * c) = o; }
    asm volatile("s_waitcnt lgkmcnt(0)" ::: "memory");
}
__device__ __forceinline__ void tr_matrix(const Ctx& C, const float* W, int ldw, int K, int ncols, int scol0, bf16_t* WT, int drow0, float scale) {
    LAS float* scr = (LAS float*)(C.lds + C.wid * 16384);
    const int nb = ncols / 32, items = (K / 64) * nb;
    for (int it = C.gw; it < items; it += C.NGW) { const int kb = it / nb, b = it % nb; tr_block(W, ldw, scol0 + 32 * b, WT, K, drow0 + 32 * b, 64 * kb, scale, scr, C.lane); }
}
struct AW { const float *w_in, *w_q, *w_k, *w_v, *w_out; };
__device__ __forceinline__ void convert_a_weights(const Ctx& C0, const AW& w, unsigned char* ws) {
    const Ctx C = relaunder(C0);
    tr_matrix(C, w.w_in, 6152, 1024, 2048, 0, (bf16_t*)(ws + WS_WXM), 0, 1.f);
    for (int h = 0; h < 4; ++h) {
        tr_matrix(C, w.w_v + (size_t)h * 262144, 512, 512, 512, 0, (bf16_t*)(ws + WS_WV), h * 512, 1.f);
        tr_matrix(C, w.w_q + (size_t)h * 262144, 512, 512, 512, 0, (bf16_t*)(ws + WS_WQK), h * 1024, 1.f);
        tr_matrix(C, w.w_k + (size_t)h * 262144, 512, 512, 512, 0, (bf16_t*)(ws + WS_WQK), h * 1024 + 512, 0.044194173824159216f);
    }
    tr_matrix(C, w.w_out, 1024, 2048, 1024, 0, (bf16_t*)(ws + WS_WOUT), 0, 1.f);
}
__device__ __forceinline__ void convert_zo_weights(const Ctx& C0, const float* w_in, unsigned char* ws) {
    const Ctx C = relaunder(C0);
    LAS float* scr = (LAS float*)(C.lds + C.wid * 16384);
    for (int it = C.gw; it < 2048; it += C.NGW) { const int pn = it >> 7, zo = (it >> 6) & 1, sub = it & 63, kb = sub >> 2, b = sub & 3;
        tr_block(w_in, 6152, 2048 + zo * 2048 + 128 * pn + 32 * b, (bf16_t*)(ws + WS_WZO), 1024, 256 * pn + 128 * zo + 32 * b, 64 * kb, 1.f, scr, C.lane); }
}
__device__ __forceinline__ void convert_b_weights(const Ctx& C0, const float* kv_w, const float* b_w_in, const float* b_w_out, unsigned char* ws) {
    const Ctx C = relaunder(C0);
    tr_matrix(C, b_w_in, 2048, 1024, 1024, 0, (bf16_t*)(ws + WS_BW0), 0, 0.125f);
    tr_matrix(C, b_w_in, 2048, 1024, 1024, 1024, (bf16_t*)(ws + WS_BW0), 1024, 1.f);
    tr_matrix(C, kv_w, 2048, 1024, 1024, 0, (bf16_t*)(ws + WS_BW0), 2048, 1.f);
    tr_matrix(C, kv_w, 2048, 1024, 1024, 1024, (bf16_t*)(ws + WS_BVW), 0, 1.f);
    tr_matrix(C, b_w_out, 1024, 1024, 1024, 0, (bf16_t*)(ws + WS_BO0), 0, 1.f);
    tr_matrix(C, b_w_in + (size_t)1024 * 2048, 2048, 1024, 1024, 0, (bf16_t*)(ws + WS_BW1), 0, 0.125f);
    tr_matrix(C, b_w_in + (size_t)1024 * 2048, 2048, 1024, 1024, 1024, (bf16_t*)(ws + WS_BW1), 1024, 1.f);
    tr_matrix(C, b_w_out + (size_t)1024 * 1024, 1024, 1024, 1024, 0, (bf16_t*)(ws + WS_BO1), 0, 1.f);
}

__device__ __forceinline__ void rows_ln(const Ctx& C0, const float* src, float* dst, bf16_t* xn, const float* g, const float* bta) {
    const Ctx C = relaunder(C0);
    for (int r = C.gw; r < M; r += C.NGW) {
        const f32x4* xr = (const f32x4*)(src + (size_t)r * DM) + C.lane;
        f32x4 v[4]; float s = 0.f;
#pragma unroll
        for (int j = 0; j < 4; ++j) { v[j] = xr[64 * j]; s += (v[j][0] + v[j][1]) + (v[j][2] + v[j][3]); }
        if (g) {
            const float mean = wave_sum(s) * (1.f / DM); float s2 = 0.f;
#pragma unroll
            for (int j = 0; j < 4; ++j) { v[j] = v[j] - mean; s2 += (v[j][0] * v[j][0] + v[j][1] * v[j][1]) + (v[j][2] * v[j][2] + v[j][3] * v[j][3]); }
            const float rstd = 1.f / sqrtf(wave_sum(s2) * (1.f / DM) + 1e-5f);
#pragma unroll
            for (int j = 0; j < 4; ++j) { const f32x4 gg = *((const f32x4*)g + C.lane + 64 * j), bb = *((const f32x4*)bta + C.lane + 64 * j); v[j] = v[j] * rstd * gg + bb; }
        }
        f32x4* o = (f32x4*)(dst + (size_t)r * DM) + C.lane; u32x2* o8 = (u32x2*)(xn + (size_t)r * DM) + C.lane;
#pragma unroll
        for (int j = 0; j < 4; ++j) { o[64 * j] = v[j]; u32x2 w; w.x = cvtpk(v[j][0], v[j][1]); w.y = cvtpk(v[j][2], v[j][3]); o8[64 * j] = w; }
    }
}

__device__ __forceinline__ void phase_a2(const Ctx& C0, const float* Xf, const float* w_in, const float* b_gate, const float* conv_w, const float* conv_b,
                                         const bf16_t* XM, bf16_t* XCb, unsigned char* ws) {
    const Ctx C = relaunder(C0);
    LAS float* Wg = (LAS float*)C.lds;
    LAS float* gl = (LAS float*)(C.lds + 32768);
    float* ipre = (float*)(ws + WS_IPRE); float* bcum = (float*)(ws + WS_BCUM); float* aarr = (float*)(ws + WS_AARR); float* amax = (float*)(ws + WS_AMAX);
    float* blast = (float*)(ws + WS_BLAST); float* am63 = (float*)(ws + WS_AM63);
    (void)ipre;
    for (int k = C.tid; k < 1024; k += 512) { const f32x4 a = *(const f32x4*)(w_in + (size_t)k * 6152 + 6144), b = *(const f32x4*)(w_in + (size_t)k * 6152 + 6148);
        *(LAS f32x4*)(Wg + k * 8) = a; *(LAS f32x4*)(Wg + k * 8 + 4) = b; }
    __syncthreads();
    for (int rb = blockIdx.x; rb < 256; rb += gridDim.x) {
        for (int i = 0; i < 8; ++i) { const int rl = 8 * C.wid + i, r = 64 * rb + rl;
            float acc[8];
#pragma unroll
            for (int g = 0; g < 8; ++g) acc[g] = 0.f;
#pragma unroll
            for (int jj = 0; jj < 4; ++jj) { const f32x4 xv = *(const f32x4*)(Xf + (size_t)r * DM + 256 * jj + 4 * C.lane);
#pragma unroll
                for (int e = 0; e < 4; ++e) { const int k = 256 * jj + 4 * C.lane + e; const f32x4 w0 = *(const LAS f32x4*)(Wg + k * 8), w1 = *(const LAS f32x4*)(Wg + k * 8 + 4);
#pragma unroll
                    for (int g = 0; g < 4; ++g) { acc[g] += xv[e] * w0[g]; acc[4 + g] += xv[e] * w1[g]; } } }
#pragma unroll
            for (int g = 0; g < 8; ++g) acc[g] = wave_sum(acc[g]);
            if (C.lane < 8) { float v = acc[0];
#pragma unroll
                for (int g = 1; g < 8; ++g) v = (C.lane == g) ? acc[g] : v;
                v += b_gate[C.lane];
                if (C.lane >= 4) v = fminf(v, 0.f) - log1pf(__expf(-fabsf(v)));
                gl[rl * 8 + C.lane] = v; }
        }
        __syncthreads();
        if (C.wid < 4) { const int h = C.wid, t = C.lane, row = 64 * rb + t;
            const float ig = gl[t * 8 + h], lf = gl[t * 8 + 4 + h];
            float bc = lf;
#pragma unroll
            for (int off = 1; off < 64; off <<= 1) { const float v = __shfl_up(bc, off); if (t >= off) bc += v; }
            const float a = ig - bc; float amx = a;
#pragma unroll
            for (int off = 1; off < 64; off <<= 1) { const float v = __shfl_up(amx, off); if (t >= off) amx = fmaxf(amx, v); }
            bcum[row * 4 + h] = bc; aarr[row * 4 + h] = a; amax[row * 4 + h] = amx;
            if (t == 63) { const int bh = (rb >> 7) * 4 + h, c = rb & 127; blast[bh * 128 + c] = bc; am63[bh * 128 + c] = amx; }
        }
        { const int cgp = C.tid & 255, hf = C.tid >> 8, c0 = 8 * cgp, r0 = 64 * rb + 32 * hf;
            float w[4][8], bs[8];
#pragma unroll
            for (int tp = 0; tp < 4; ++tp) { const f32x4 a = *(const f32x4*)(conv_w + tp * 2048 + c0), b = *(const f32x4*)(conv_w + tp * 2048 + c0 + 4);
#pragma unroll
                for (int e = 0; e < 4; ++e) { w[tp][e] = a[e]; w[tp][4 + e] = b[e]; } }
            { const f32x4 a = *(const f32x4*)(conv_b + c0), b = *(const f32x4*)(conv_b + c0 + 4);
#pragma unroll
                for (int e = 0; e < 4; ++e) { bs[e] = a[e]; bs[4 + e] = b[e]; } }
            u32x4 x0 = {0, 0, 0, 0}, x1 = x0, x2 = x0;
            if ((r0 & 8191) != 0) { x0 = *(const u32x4*)(XM + (size_t)(r0 - 3) * 2048 + c0); x1 = *(const u32x4*)(XM + (size_t)(r0 - 2) * 2048 + c0); x2 = *(const u32x4*)(XM + (size_t)(r0 - 1) * 2048 + c0); }
            for (int i = 0; i < 32; ++i) { const u32x4 x3 = *(const u32x4*)(XM + (size_t)(r0 + i) * 2048 + c0);
                float o[8];
#pragma unroll
                for (int p = 0; p < 4; ++p) {
                    o[2 * p] = bs[2 * p] + w[0][2 * p] * bflo(x0[p]) + w[1][2 * p] * bflo(x1[p]) + w[2][2 * p] * bflo(x2[p]) + w[3][2 * p] * bflo(x3[p]);
                    o[2 * p + 1] = bs[2 * p + 1] + w[0][2 * p + 1] * bfhi(x0[p]) + w[1][2 * p + 1] * bfhi(x1[p]) + w[2][2 * p + 1] * bfhi(x2[p]) + w[3][2 * p + 1] * bfhi(x3[p]); }
#pragma unroll
                for (int e = 0; e < 8; ++e) o[e] = o[e] * sigmoidf_(o[e]);
                u32x4 ov; ov.x = cvtpk(o[0], o[1]); ov.y = cvtpk(o[2], o[3]); ov.z = cvtpk(o[4], o[5]); ov.w = cvtpk(o[6], o[7]);
                *(u32x4*)(XCb + (size_t)(r0 + i) * 2048 + c0) = ov; x0 = x1; x1 = x2; x2 = x3; }
        }
        __syncthreads();
    }
}

__device__ __forceinline__ void phase_pa(const Ctx& C0, int seg, bf16_t* Qs, bf16_t* Ks, unsigned char* ws) {
    const Ctx C = relaunder(C0);
    LAS float* sa = (LAS float*)C.lds; LAS float* sM = sa + 64; LAS float* swi = sa + 128; LAS float* swg = sa + 192; LAS float* dpart = sa + 256;
    const float* bcum = (const float*)(ws + WS_BCUM); const float* aarr = (const float*)(ws + WS_AARR); const float* amaxa = (const float*)(ws + WS_AMAX);
    const float* blast = (const float*)(ws + WS_BLAST); const float* am63 = (const float*)(ws + WS_AM63);
    float* decay = (float*)(ws + WS_DECAY); float* densum = (float*)(ws + WS_DENSUM); float* eclamp = (float*)(ws + WS_ECLAMP); float* ksum = (float*)(ws + WS_KSUM);
    bf16_t* SW = (bf16_t*)(ws + WS_SW);
    const int lane = C.lane, m = lane & 15, q = lane >> 4, w = C.wid;
    for (int ul = blockIdx.x; ul < 512; ul += gridDim.x) {
        const int bh = ul >> 6, cl = ul & 63, c = seg * 64 + cl, b = bh >> 2, h = bh & 3;
        const int srow0 = b * 4096 + cl * 64, row0 = b * 8192 + c * 64, ug = bh * 128 + c;
        if (w == 0) {
            const float bl0 = blast[bh * 128 + lane], bl1 = blast[bh * 128 + 64 + lane], am0 = am63[bh * 128 + lane], am1 = am63[bh * 128 + 64 + lane];
            float mp = 0.f;
            for (int cc = 0; cc < c; ++cc) { const float bl = __shfl(cc < 64 ? bl0 : bl1, cc & 63), am = __shfl(cc < 64 ? am0 : am1, cc & 63); mp = bl + fmaxf(mp, am); }
            const int t = lane; const float a_t = aarr[(row0 + t) * 4 + h], amx = amaxa[(row0 + t) * 4 + h], bc = bcum[(row0 + t) * 4 + h];
            const float Mt = fmaxf(mp, amx), Mlast = __shfl(Mt, 63);
            sa[t] = a_t; sM[t] = Mt; swi[t] = __expf(mp - Mt); swg[t] = __expf(a_t - Mlast);
            eclamp[(row0 + t) * 4 + h] = __expf(-(bc + Mt));
            if (t == 0) decay[ug] = __expf(mp - Mlast);
        }
        __syncthreads();
        { const int mt = w & 3, ntp = w >> 2;
            f32x4 a0 = {0.f, 0.f, 0.f, 0.f}, a1 = a0;
            const bf16_t* qp = Qs + (size_t)(srow0 + 16 * mt + m) * 2048 + h * 512 + 8 * q;
            const bf16_t* kp0 = Ks + (size_t)(srow0 + 32 * ntp + m) * 2048 + h * 512 + 8 * q; const bf16_t* kp1 = kp0 + (size_t)16 * 2048;
#pragma unroll 4
            for (int kk = 0; kk < 16; ++kk) { const bf16x8 a = *(const bf16x8*)(qp + 32 * kk), b0 = *(const bf16x8*)(kp0 + 32 * kk), b1 = *(const bf16x8*)(kp1 + 32 * kk);
                a0 = __builtin_amdgcn_mfma_f32_16x16x32_bf16(a, b0, a0, 0, 0, 0); a1 = __builtin_amdgcn_mfma_f32_16x16x32_bf16(a, b1, a1, 0, 0, 0); }
            float rs[4];
#pragma unroll
            for (int j = 0; j < 4; ++j) { const int t = 16 * mt + 4 * q + j, s0 = 32 * ntp + m, s1 = s0 + 16; const float Mt = sM[t];
                const float v0 = (s0 <= t) ? a0[j] * __expf(sa[s0] - Mt) : 0.f, v1 = (s1 <= t) ? a1[j] * __expf(sa[s1] - Mt) : 0.f;
                SW[(size_t)ul * 4096 + t * 64 + s0] = (bf16_t)(cvtpk(v0, 0.f) & 0xffffu); SW[(size_t)ul * 4096 + t * 64 + s1] = (bf16_t)(cvtpk(v1, 0.f) & 0xffffu);
                float r = v0 + v1; r += __shfl_xor(r, 1); r += __shfl_xor(r, 2); r += __shfl_xor(r, 4); r += __shfl_xor(r, 8); rs[j] = r; }
            if (m == 0) {
#pragma unroll
                for (int j = 0; j < 4; ++j) dpart[ntp * 64 + 16 * mt + 4 * q + j] = rs[j]; }
        }
        { const int dk = C.tid; float ks = 0.f; const bf16_t* kp = Ks + (size_t)srow0 * 2048 + h * 512 + dk;
#pragma unroll 8
            for (int s = 0; s < 64; ++s) ks += swg[s] * bf2f(kp[(size_t)s * 2048]);
            ksum[(size_t)ug * 512 + dk] = ks; }
        __syncthreads();
        if (C.tid < 64) densum[(row0 + C.tid) * 4 + h] = dpart[C.tid] + dpart[64 + C.tid];
#pragma unroll
        for (int i = 0; i < 8; ++i) { const int id = C.tid + 512 * i, r = id >> 6, ch = id & 63;
            u32x4* qp = (u32x4*)(Qs + (size_t)(srow0 + r) * 2048 + h * 512 + ch * 8); u32x4* kp = (u32x4*)(Ks + (size_t)(srow0 + r) * 2048 + h * 512 + ch * 8);
            u32x4 qv = *qp, kv = *kp; const float fq_ = swi[r], fk_ = swg[r];
#pragma unroll
            for (int e = 0; e < 4; ++e) { qv[e] = cvtpk(bflo(qv[e]) * fq_, bfhi(qv[e]) * fq_); kv[e] = cvtpk(bflo(kv[e]) * fk_, bfhi(kv[e]) * fk_); }
            *qp = qv; *kp = kv; }
        __syncthreads();
    }
}

__device__ __forceinline__ void phase_pb(const Ctx& C0, int seg, const bf16_t* Qs, const bf16_t* Ks, bf16_t* V, unsigned char* ws) {
    const Ctx C = relaunder(C0);
    const float* ksum = (const float*)(ws + WS_KSUM); const float* decay = (const float*)(ws + WS_DECAY); const float* densum = (const float*)(ws + WS_DENSUM);
    const float* eclamp = (const float*)(ws + WS_ECLAMP); float* den = (float*)(ws + WS_DEN); float* Cst = (float*)(ws + WS_CST); float* nst = (float*)(ws + WS_NST);
    const bf16_t* SW = (const bf16_t*)(ws + WS_SW);
    const int lane = C.lane, m = lane & 15, q = lane >> 4, w = C.wid, tid = C.tid;
    LAS unsigned char* kt = C.lds + w * 9216;
    LAS unsigned char* vs = C.lds + 73728;
    LAS float* red = (LAS float*)(C.lds + 75776);
    LAS float* redS = (LAS float*)(C.lds + 108544);
    LAS float* redq = (LAS float*)(C.lds + 116736);
    for (int wg = blockIdx.x; wg < 256; wg += gridDim.x) {
        const int bh = wg >> 5, sl = wg & 31, b = bh >> 2, h = bh & 3;
        f32x4 T[2][2]; float nv;
#pragma unroll
        for (int ks = 0; ks < 2; ++ks) {
#pragma unroll
            for (int hf = 0; hf < 2; ++hf)
#pragma unroll
                for (int j = 0; j < 4; ++j) { const int dk = 64 * w + 32 * ks + 8 * q + 4 * hf + j; T[ks][hf][j] = seg == 0 ? 0.f : Cst[((size_t)bh * 512 + dk) * 512 + 16 * sl + m]; }
        }
        nv = seg == 0 ? 0.f : nst[bh * 512 + 64 * w + 32 * (m >> 3) + 8 * q + (m & 7)];
        u32x4 kr[8]; bf16x8 qa[4][2]; u32x4 vr = {0, 0, 0, 0}; float ksv;
        const unsigned voffK = (unsigned)(((lane >> 3) * 2048 + (lane & 7) * 8) * 2), voffQ = (unsigned)((m * 2048 + 8 * q) * 2), voffV = (unsigned)(((tid >> 1) * 2048 + 8 * (tid & 1)) * 2), voffS = (unsigned)((32 * (m >> 3) + 8 * q + (m & 7)) * 4);
        const __amdgpu_buffer_rsrc_t rK = __builtin_amdgcn_make_buffer_rsrc((void*)Ks, 0, 0x7fffffff, 0x00020000), rQ = __builtin_amdgcn_make_buffer_rsrc((void*)Qs, 0, 0x7fffffff, 0x00020000),
                                     rV = __builtin_amdgcn_make_buffer_rsrc((void*)V, 0, 0x7fffffff, 0x00020000), rS = __builtin_amdgcn_make_buffer_rsrc((void*)ksum, 0, 0x7fffffff, 0x00020000);
#define PB_ISSUE(cl_) do { const int srow0_ = b * 4096 + (cl_) * 64, row0_ = b * 8192 + (seg * 64 + (cl_)) * 64, ug_ = bh * 128 + seg * 64 + (cl_); \
            const int kb_ = (srow0_ * 2048 + h * 512 + 64 * w) * 2; \
            _Pragma("unroll") for (int i = 0; i < 8; ++i) kr[i] = __builtin_amdgcn_raw_buffer_load_b128(rK, voffK, kb_ + i * 32768, 0); \
            const int vb_ = (row0_ * 2048 + h * 512 + 16 * sl) * 2; \
            if (tid < 128) vr = __builtin_amdgcn_raw_buffer_load_b128(rV, voffV, vb_, 0); \
            const int sb_ = (ug_ * 512 + 64 * w) * 4; \
            ksv = __builtin_bit_cast(float, __builtin_amdgcn_raw_buffer_load_b32(rS, voffS, sb_, 0)); } while (0)
#define PB_ISSUE_Q(cl_) do { const int srow0_ = b * 4096 + (cl_) * 64; const int qb_ = (srow0_ * 2048 + h * 512 + 64 * w) * 2; \
            _Pragma("unroll") for (int mt = 0; mt < 4; ++mt) _Pragma("unroll") for (int ks = 0; ks < 2; ++ks) qa[mt][ks] = __builtin_bit_cast(bf16x8, __builtin_amdgcn_raw_buffer_load_b128(rQ, voffQ, qb_ + mt * 65536 + ks * 64, 0)); } while (0)
        PB_ISSUE(0); PB_ISSUE_Q(0);
        for (int cl = 0; cl < 64; ++cl) {
            const int c = seg * 64 + cl, row0 = b * 8192 + c * 64, ul = bh * 64 + cl, ug = bh * 128 + c;
#pragma unroll
            for (int i = 0; i < 8; ++i) *(LAS u32x4*)(kt + ((lane >> 3) + 8 * i) * 144 + (lane & 7) * 16) = kr[i];
            if (tid < 128) *(LAS u32x4*)(vs + (tid >> 1) * 32 + (tid & 1) * 16) = vr;
            const float ksc = ksv;
            const float dcy = decay[ug];
            const bf16x8 swa = *(const bf16x8*)(SW + (size_t)ul * 4096 + (16 * (w & 3) + m) * 64 + 32 * (w >> 2) + 8 * q);
            __syncthreads();
            const int cln = cl < 63 ? cl + 1 : cl;
            bf16x8 cb[2];
#pragma unroll
            for (int ks = 0; ks < 2; ++ks) { u32x4 pk; pk.x = cvtpk(T[ks][0][0], T[ks][0][1]); pk.y = cvtpk(T[ks][0][2], T[ks][0][3]); pk.z = cvtpk(T[ks][1][0], T[ks][1][1]); pk.w = cvtpk(T[ks][1][2], T[ks][1][3]); cb[ks] = __builtin_bit_cast(bf16x8, pk); }
            bf16x8 vb[2];
#pragma unroll
            for (int kss = 0; kss < 2; ++kss) { const s16x4 lo = tr16(vs + (32 * kss + 8 * q + (m >> 2)) * 32 + (m & 3) * 8), hi = tr16(vs + (32 * kss + 8 * q + 4 + (m >> 2)) * 32 + (m & 3) * 8);
                vb[kss] = (bf16x8){lo[0], lo[1], lo[2], lo[3], hi[0], hi[1], hi[2], hi[3]}; }
            bf16x8 nb[2];
#pragma unroll
            for (int ks = 0; ks < 2; ++ks) { float g[8];
#pragma unroll
                for (int jj = 0; jj < 8; ++jj) g[jj] = __shfl(nv, (lane & 48) | (8 * ks + jj));
                u32x4 pk; pk.x = cvtpk(g[0], g[1]); pk.y = cvtpk(g[2], g[3]); pk.z = cvtpk(g[4], g[5]); pk.w = cvtpk(g[6], g[7]);
                if (m != 0) pk = (u32x4){0u, 0u, 0u, 0u}; nb[ks] = __builtin_bit_cast(bf16x8, pk); }
#pragma unroll
            for (int mt = 0; mt < 4; ++mt) {
                f32x4 p = {0.f, 0.f, 0.f, 0.f}, pn = {0.f, 0.f, 0.f, 0.f};
                p = __builtin_amdgcn_mfma_f32_16x16x32_bf16(qa[mt][0], cb[0], p, 0, 0, 0); p = __builtin_amdgcn_mfma_f32_16x16x32_bf16(qa[mt][1], cb[1], p, 0, 0, 0);
                pn = __builtin_amdgcn_mfma_f32_16x16x32_bf16(qa[mt][0], nb[0], pn, 0, 0, 0); pn = __builtin_amdgcn_mfma_f32_16x16x32_bf16(qa[mt][1], nb[1], pn, 0, 0, 0);
#pragma unroll
                for (int j = 0; j < 4; ++j) red[(w * 64 + 16 * mt + 4 * q + j) * 16 + m] = p[j];
                if (m == 0) {
#pragma unroll
                    for (int j = 0; j < 4; ++j) redq[w * 64 + 16 * mt + 4 * q + j] = pn[j]; }
            }
            PB_ISSUE(cln); PB_ISSUE_Q(cln);
            { f32x4 sv = {0.f, 0.f, 0.f, 0.f}; const int kss = w >> 2;
                sv = __builtin_amdgcn_mfma_f32_16x16x32_bf16(swa, kss ? vb[1] : vb[0], sv, 0, 0, 0);
#pragma unroll
                for (int j = 0; j < 4; ++j) redS[(kss * 64 + 16 * (w & 3) + 4 * q + j) * 16 + m] = sv[j]; }
#pragma unroll
            for (int ks = 0; ks < 2; ++ks) {
#pragma unroll
                for (int hf = 0; hf < 2; ++hf) { f32x4 t = T[ks][hf] * dcy;
#pragma unroll
                    for (int kss = 0; kss < 2; ++kss) { const LAS unsigned char* ap = kt + (32 * kss + 8 * q + (m >> 2)) * 144 + (32 * ks + 8 * (m & 3) + 4 * hf) * 2;
                        const s16x4 lo = tr16(ap), hi = tr16(ap + 4 * 144);
                        const bf16x8 ka = (bf16x8){lo[0], lo[1], lo[2], lo[3], hi[0], hi[1], hi[2], hi[3]};
                        t = __builtin_amdgcn_mfma_f32_16x16x32_bf16(ka, vb[kss], t, 0, 0, 0); }
                    T[ks][hf] = t; }
            }
            nv = dcy * nv + ksc;
            __syncthreads();
            { const int t = tid >> 3, pr = tid & 7; float s0 = redS[t * 16 + 2 * pr] + redS[(64 + t) * 16 + 2 * pr], s1 = redS[t * 16 + 2 * pr + 1] + redS[(64 + t) * 16 + 2 * pr + 1];
#pragma unroll
                for (int ww = 0; ww < 8; ++ww) { s0 += red[(ww * 64 + t) * 16 + 2 * pr]; s1 += red[(ww * 64 + t) * 16 + 2 * pr + 1]; }
                *(unsigned*)(V + (size_t)(row0 + t) * 2048 + h * 512 + 16 * sl + 2 * pr) = cvtpk(s0, s1);
                if (sl == 0 && pr == 0) { float qn = 0.f;
#pragma unroll
                    for (int ww = 0; ww < 8; ++ww) qn += redq[ww * 64 + t];
                    const float dn = densum[(row0 + t) * 4 + h] + qn; den[(row0 + t) * 4 + h] = fmaxf(fabsf(dn), eclamp[(row0 + t) * 4 + h]); } }
        }
#undef PB_ISSUE
#undef PB_ISSUE_Q
        if (seg == 0) {
#pragma unroll
            for (int ks = 0; ks < 2; ++ks) {
#pragma unroll
                for (int hf = 0; hf < 2; ++hf)
#pragma unroll
                    for (int j = 0; j < 4; ++j) { const int dk = 64 * w + 32 * ks + 8 * q + 4 * hf + j; Cst[((size_t)bh * 512 + dk) * 512 + 16 * sl + m] = T[ks][hf][j]; }
            }
            if (sl == 0) nst[bh * 512 + 64 * w + 32 * (m >> 3) + 8 * q + (m & 7)] = nv;
        }
        __syncthreads();
    }
}

__device__ __forceinline__ void phase_stats(const Ctx& C0, const bf16_t* NUM, unsigned char* ws) {
    const Ctx C = relaunder(C0);
    const float* den = (const float*)(ws + WS_DEN); float* gn = (float*)(ws + WS_GNSTAT);
    for (int it = C.gw; it < M * 4; it += C.NGW) { const int row = it >> 2, h = it & 3;
        const u32x4 raw = *(const u32x4*)(NUM + (size_t)row * 2048 + h * 512 + 8 * C.lane);
        float v[8]; float s = 0.f;
#pragma unroll
        for (int e = 0; e < 4; ++e) { v[2 * e] = bflo(raw[e]); v[2 * e + 1] = bfhi(raw[e]); s += v[2 * e] + v[2 * e + 1]; }
        const float mean = wave_sum(s) * (1.f / 512.f); float q2 = 0.f;
#pragma unroll
        for (int e = 0; e < 8; ++e) { const float d = v[e] - mean; q2 += d * d; }
        const float var = wave_sum(q2) * (1.f / 512.f), dn = den[it];
        if (C.lane == 0) { gn[(size_t)it * 2] = mean; gn[(size_t)it * 2 + 1] = 1.0f / sqrtf(var + 1e-6f * dn * dn); }
    }
}

__device__ __forceinline__ void phase_attn(const Ctx& C0, const bf16_t* QB, const bf16_t* KB, const bf16_t* VT, const bf16_t* GB, bf16_t* OG, const float* relb) {
    const Ctx C = relaunder(C0);
    LAS float* sb = (LAS float*)C.lds;
    for (int i = C.tid; i < 16 * 257; i += 512) sb[i] = relb[i];
    __syncthreads();
    const int lane = C.lane, n = lane & 15, q = lane >> 4;
    for (int it = C.gw; it < 16384; it += C.NGW) {
        const int qb = it & 3, h = (it >> 2) & 15, c = (it >> 6) & 127, b = it >> 13;
        const int qrow0 = b * 8192 + 64 * c + 16 * qb;
        bf16x8 qf[2];
#pragma unroll
        for (int ks = 0; ks < 2; ++ks) qf[ks] = *(const bf16x8*)(QB + (size_t)(qrow0 + n) * 1024 + h * 64 + 32 * ks + 8 * q);
        f32x4 o[4];
#pragma unroll
        for (int mt = 0; mt < 4; ++mt) o[mt] = (f32x4){0.f, 0.f, 0.f, 0.f};
        float mrun = -1e30f, lrun = 0.f;
        const int st0 = c < 8 ? (16 - 2 * c) : 0;
        for (int st = st0; st < 18; ++st) {
            const int kpos0 = 64 * c - 512 + 32 * st;
            f32x4 s0 = {0.f, 0.f, 0.f, 0.f}, s1 = s0;
            const bf16_t* kp = KB + (size_t)(b * 8192 + kpos0 + 8 * (n >> 2) + (n & 3)) * 1024 + h * 64 + 8 * q;
#pragma unroll
            for (int ks = 0; ks < 2; ++ks) { const bf16x8 k0 = *(const bf16x8*)(kp + 32 * ks), k1 = *(const bf16x8*)(kp + (size_t)4 * 1024 + 32 * ks);
                s0 = __builtin_amdgcn_mfma_f32_16x16x32_bf16(k0, qf[ks], s0, 0, 0, 0); s1 = __builtin_amdgcn_mfma_f32_16x16x32_bf16(k1, qf[ks], s1, 0, 0, 0); }
            bf16x8 va[4];
#pragma unroll
            for (int mt = 0; mt < 4; ++mt) va[mt] = *(const bf16x8*)(VT + (size_t)(h * 64 + 16 * mt + n) * 16384 + b * 8192 + kpos0 + 8 * q);
            const int dq0 = (64 * c + 16 * qb + n) - (kpos0 + 8 * q);
            float sc[8]; float mx = -1e30f;
#pragma unroll
            for (int jj = 0; jj < 8; ++jj) { int d = dq0 - jj; d = d < -128 ? -128 : (d > 128 ? 128 : d); sc[jj] = (jj < 4 ? s0[jj & 3] : s1[jj & 3]) + sb[h * 257 + d + 128]; mx = fmaxf(mx, sc[jj]); }
            mx = fmaxf(mx, __shfl_xor(mx, 16)); mx = fmaxf(mx, __shfl_xor(mx, 32));
            const float mnew = fmaxf(mrun, mx), scale = __expf(mrun - mnew);
            float ps = 0.f;
#pragma unroll
            for (int jj = 0; jj < 8; ++jj) { sc[jj] = __expf(sc[jj] - mnew); ps += sc[jj]; }
            lrun = lrun * scale + ps; mrun = mnew;
            u32x4 pk; pk.x = cvtpk(sc[0], sc[1]); pk.y = cvtpk(sc[2], sc[3]); pk.z = cvtpk(sc[4], sc[5]); pk.w = cvtpk(sc[6], sc[7]);
            const bf16x8 pb = __builtin_bit_cast(bf16x8, pk);
#pragma unroll
            for (int mt = 0; mt < 4; ++mt) { o[mt] = o[mt] * scale; o[mt] = __builtin_amdgcn_mfma_f32_16x16x32_bf16(va[mt], pb, o[mt], 0, 0, 0); }
        }
        float lt = lrun + __shfl_xor(lrun, 16); lt += __shfl_xor(lt, 32);
        const float inv = 1.0f / lt;
#pragma unroll
        for (int mt = 0; mt < 4; ++mt) { const size_t off = (size_t)(qrow0 + n) * 1024 + h * 64 + 16 * mt + 4 * q;
            const u32x2 g = *(const u32x2*)(GB + off); const float gv[4] = {bflo(g.x), bfhi(g.x), bflo(g.y), bfhi(g.y)};
            float r[4];
#pragma unroll
            for (int e = 0; e < 4; ++e) r[e] = o[mt][e] * inv * (gv[e] * sigmoidf_(gv[e]));
            u32x2 wv; wv.x = cvtpk(r[0], r[1]); wv.y = cvtpk(r[2], r[3]); *(u32x2*)(OG + off) = wv; }
    }
    __syncthreads();
}


#define XB_TMO      128
#define XB_XCNT(j)  (256  + 64 * (j))
#define XB_XSUB(j)  (1280 + 64 * (j))
#define XB_XGEN(j)  (2304 + 64 * (j))
#define XB_TOP      3328
#define XB_TOPGEN   3392
#define XCD_BAR_WORDS 3456
#define XB_SPIN_CAP (1u << 22)
__device__ __forceinline__ unsigned xb_ld(unsigned* p)              { return __hip_atomic_load(p, __ATOMIC_RELAXED, __HIP_MEMORY_SCOPE_AGENT); }
__device__ __forceinline__ unsigned xb_add(unsigned* p, unsigned v) { return __hip_atomic_fetch_add(p, v, __ATOMIC_RELAXED, __HIP_MEMORY_SCOPE_AGENT); }
__device__ __forceinline__ unsigned xb_xcc_id() { return (unsigned)__builtin_amdgcn_s_getreg((3 << 11) | 20) & 0xFu; }
#define XB_SPIN(cond, bar) do { unsigned _sp = 0; while (cond) { __builtin_amdgcn_s_sleep(1); \
    if ((++_sp & 255u) == 0u) { if (xb_ld(&(bar)[XB_TMO])) break; if (_sp > XB_SPIN_CAP) { atomicAdd(&(bar)[XB_TMO], 1u); break; } } } } while (0)
struct XcdBarrier { unsigned* bar; unsigned x; volatile LAS unsigned* st; };
__device__ __forceinline__ XcdBarrier xcd_barrier_post(unsigned* bar, volatile LAS unsigned* st) {
    XcdBarrier b; b.bar = bar; b.x = xb_xcc_id(); b.st = st;
    if (threadIdx.x == 0) (void)xb_add(&bar[XB_XCNT(b.x)], 1u);
    return b;
}
__device__ __forceinline__ void xcd_barrier_complete(unsigned* bar, unsigned x, unsigned& nloc, unsigned& nx) {
    const unsigned G = gridDim.x * gridDim.y * gridDim.z;
    unsigned sum, cnt, mine, sp = 0u;
    for (;;) {
        sum = 0u; cnt = 0u; mine = 0u;
#pragma unroll
        for (unsigned j = 0; j < 16; ++j) { const unsigned c = xb_ld(&bar[XB_XCNT(j)]); sum += c; cnt += (c > 0u) ? 1u : 0u; mine = (j == x) ? c : mine; }
        if (sum == G) break;
        __builtin_amdgcn_s_sleep(1);
        if ((++sp & 255u) == 0u) { if (xb_ld(&bar[XB_TMO])) break; if (sp > XB_SPIN_CAP) { atomicAdd(&bar[XB_TMO], 1u); break; } }
    }
    nloc = mine > 0u ? mine : 1u; nx = cnt > 0u ? cnt : 1u;
}
__device__ __forceinline__ void xcd_barrier(unsigned* bar, unsigned x, volatile LAS unsigned* st) {
    asm volatile("s_waitcnt vmcnt(0)" ::: "memory");
    __syncthreads();
    if (threadIdx.x == 0) {
        __builtin_amdgcn_s_waitcnt(0);
        unsigned nloc = st[0], nx = st[1];
        if (nloc == 0u) { xcd_barrier_complete(bar, x, nloc, nx); st[0] = nloc; st[1] = nx; }
        const unsigned old = xb_add(&bar[XB_XSUB(x)], 1u);
        const unsigned gen = old / nloc;
        if (old + 1u == (gen + 1u) * nloc) {
            __builtin_amdgcn_fence(__ATOMIC_RELEASE, "agent");
            asm volatile("s_waitcnt vmcnt(0)" ::: "memory");
            const unsigned og = xb_add(&bar[XB_TOP], 1u);
            const unsigned tg = og / nx;
            if (og + 1u == (tg + 1u) * nx) xb_add(&bar[XB_TOPGEN], 1u);
            else XB_SPIN(xb_ld(&bar[XB_TOPGEN]) == tg, bar);
            __builtin_amdgcn_fence(__ATOMIC_ACQUIRE, "agent");
            xb_add(&bar[XB_XGEN(x)], 1u);
            asm volatile("s_waitcnt vmcnt(0)" ::: "memory");
        } else {
            XB_SPIN(xb_ld(&bar[XB_XGEN(x)]) == gen, bar);
            __builtin_amdgcn_fence(__ATOMIC_ACQUIRE, "agent");
            asm volatile("s_waitcnt vmcnt(0)" ::: "memory");
        }
    }
    __syncthreads();
}

struct Params { const float* in[19]; float* out; unsigned char* ws; };
typedef const __attribute__((address_space(4))) Params* KP;
__device__ __forceinline__ KP kargs() { KP q = (KP)__builtin_amdgcn_kernarg_segment_ptr(); asm volatile("" : "+s"(q)); return q; }

__global__ void __launch_bounds__(512) fwd_megakernel(Params p_unused) {
    extern __shared__ __attribute__((aligned(16))) unsigned char lds_raw[];
    cg::grid_group grid = cg::this_grid();
    Ctx C; C.lds = (LAS unsigned char*)lds_raw; C.tid = threadIdx.x; C.lane = C.tid & 63; C.wid = __builtin_amdgcn_readfirstlane(C.tid >> 6);
    C.gw = blockIdx.x * 8 + C.wid; C.NGW = gridDim.x * 8;
    const int G = gridDim.x, cidx = blockIdx.x;
    volatile LAS unsigned long long* tl = (volatile LAS unsigned long long*)(C.lds + 140000);
    if (PROBE_MASK && threadIdx.x == 0) tl[0] = 0ull;
#define PH(id, ...) { if (((PROBE_MASK >> (id)) & 1) && threadIdx.x == 0) tl[1] = __builtin_amdgcn_s_memrealtime(); __VA_ARGS__ if (((PROBE_MASK >> (id)) & 1) && threadIdx.x == 0) tl[0] += __builtin_amdgcn_s_memrealtime() - tl[1]; }
#define GSYNC() PH(6, xcd_barrier((unsigned*)(WSP + WS_BAR), xb_xcc_id(), (volatile LAS unsigned*)(C.lds + 140032));)
#define WSP (kargs()->ws)
#define INP(i) (kargs()->in[i])
#define XP (kargs()->out)
#define XNP ((bf16_t*)(WSP + WS_XN))
#define B0P ((bf16_t*)(WSP + WS_BUF0))
#define B1P ((bf16_t*)(WSP + WS_BUF1))
#define B2P ((bf16_t*)(WSP + WS_BUF2))
    if (threadIdx.x == 0) { volatile LAS unsigned* st = (volatile LAS unsigned*)(C.lds + 140032); st[0] = 0u; st[1] = 0u; }
    if (blockIdx.x == 0) { unsigned* bar = (unsigned*)(WSP + WS_BAR); for (int i = threadIdx.x; i < XCD_BAR_WORDS; i += 512) bar[i] = 0u; }
    __syncthreads();
    PH(5, rows_ln(C, INP(0), XP, XNP, nullptr, nullptr); { AW w{INP(1), INP(5), INP(6), INP(7), INP(10)}; convert_a_weights(C, w, WSP); })
    PH(6, grid.sync();)
    if (threadIdx.x == 0) (void)xb_add(&((unsigned*)(WSP + WS_BAR))[XB_XCNT(xb_xcc_id())], 1u);

    for (int l = 0; l < 2; ++l) {
        PH(0, { unsigned char* ws = WSP; Sched S; S.init(64, 8, G, cidx, ws + WS_XN, ws + WS_WXM, 1024, 1024); EpiPlain E{(bf16_t*)(ws + WS_BUF0), 2048}; pg8::gemm_phase(C.lds, S, 1024, 1024, 1024, E); })
        GSYNC();
        PH(4, phase_a2(C, XP, INP(1) + (size_t)l * 1024 * 6152, INP(2) + l * 8, INP(3) + (size_t)l * 4 * 2048, INP(4) + l * 2048, B0P, B1P, WSP);)
        PH(0, { unsigned char* ws = WSP; Sched S; S.init(64, 8, G, cidx, ws + WS_BUF0, ws + WS_WV, 2048, 512); S.grp_shift = 1; S.a_grp_bytes = 1024; EpiPlain E{(bf16_t*)(ws + WS_BUF2), 2048}; pg8::gemm_phase(C.lds, S, 512, 2048, 512, E); })
        GSYNC();
        for (int seg = 0; seg < 2; ++seg) {
            PH(0, { unsigned char* ws = WSP; Sched S; S.init(32, 16, G, cidx, ws + WS_BUF1, ws + WS_WQK, 2048, 512); S.seg = seg; S.grp_shift = 2; S.a_grp_bytes = 1024; EpiQK E{(bf16_t*)(ws + WS_BUF0), (size_t)8192 * 2048, seg}; pg8::gemm_phase(C.lds, S, 512, 2048, 512, E); })
            GSYNC();
            PH(2, phase_pa(C, seg, B0P, B0P + (size_t)8192 * 2048, WSP);)
            GSYNC();
            PH(1, phase_pb(C, seg, B0P, B0P + (size_t)8192 * 2048, B2P, WSP);)
            GSYNC();
        }
        PH(5, phase_stats(C, B2P, WSP); convert_zo_weights(C, INP(1) + (size_t)l * 1024 * 6152, WSP);)
        GSYNC();
        PH(0, { unsigned char* ws = WSP; Sched S; S.init(64, 16, G, cidx, ws + WS_XN, ws + WS_WZO, 1024, 1024);
          EpiGate E{(bf16_t*)(ws + WS_BUF2), (bf16_t*)(ws + WS_BUF1), (const float*)(ws + WS_GNSTAT), INP(8) + l * 2048, INP(9) + l * 2048, (bf16_t*)(ws + WS_BUF0)};
          pg8::gemm_phase(C.lds, S, 1024, 1024, 1024, E); })
        GSYNC();
        PH(0, { unsigned char* ws = WSP; Sched S; S.init(64, 4, G, cidx, ws + WS_BUF0, ws + WS_WOUT, 2048, 2048); EpiResid E{XP}; pg8::gemm_phase(C.lds, S, 2048, 2048, 2048, E); })
        GSYNC();
        PH(5, rows_ln(C, XP, XP, XNP, INP(11) + l * 1024, INP(12) + l * 1024);
        if (l == 0) { AW w{INP(1) + (size_t)1024 * 6152, INP(5) + (size_t)4 * 262144, INP(6) + (size_t)4 * 262144, INP(7) + (size_t)4 * 262144, INP(10) + (size_t)2048 * 1024}; convert_a_weights(C, w, WSP); }
        else convert_b_weights(C, INP(13), INP(14), INP(16), WSP);)
        GSYNC();
    }
    for (int l = 0; l < 2; ++l) {
        PH(0, { unsigned char* ws = WSP; Sched S; S.init(64, l == 0 ? 12 : 8, G, cidx, ws + WS_XN, ws + (l == 0 ? WS_BW0 : WS_BW1), 1024, 1024); EpiSplit3 E{(bf16_t*)(ws + WS_QB), (size_t)16 * 1024 * 1024}; pg8::gemm_phase(C.lds, S, 1024, 1024, 1024, E); })
        PH(0, if (l == 0) { unsigned char* ws = WSP; Sched S; S.init(4, 64, G, cidx, ws + WS_BVW, ws + WS_XN, 1024, 1024); EpiPlain E{(bf16_t*)(ws + WS_VT), 16384}; pg8::gemm_phase(C.lds, S, 1024, 1024, 1024, E); })
        GSYNC();
        PH(3, { unsigned char* ws = WSP; phase_attn(C, (const bf16_t*)(ws + WS_QB), (const bf16_t*)(ws + WS_KB), (const bf16_t*)(ws + WS_VT), (const bf16_t*)(ws + WS_GB), (bf16_t*)(ws + WS_OG), INP(15) + (size_t)l * 16 * 257); })
        GSYNC();
        PH(0, { unsigned char* ws = WSP; Sched S; S.init(64, 4, G, cidx, ws + WS_OG, ws + (l == 0 ? WS_BO0 : WS_BO1), 1024, 1024); EpiResid E{XP}; pg8::gemm_phase(C.lds, S, 1024, 1024, 1024, E); })
        GSYNC();
        PH(5, rows_ln(C, XP, XP, XNP, INP(17) + l * 1024, INP(18) + l * 1024);)
        if (l == 0) GSYNC();
    }
    if (PROBE_MASK && blockIdx.x == 0 && threadIdx.x == 0) { const unsigned long long t0 = __builtin_amdgcn_s_memrealtime(), ta = tl[0]; while (__builtin_amdgcn_s_memrealtime() - t0 < ta) __builtin_amdgcn_s_sleep(8); }
}

extern "C" void kernel_launch(void* const* d_in, const int* in_sizes, int n_in, void* d_out, int out_size, void* d_ws, size_t ws_size, hipStream_t stream) {
    static int grid = 0;
    if (grid == 0) {
        if (n_in != 19 || out_size != M * DM || ws_size < WS_END) { fprintf(stderr, "kernel_launch: unexpected problem (n_in %d out %d ws %zu)\n", n_in, out_size, ws_size); grid = -1; return; }
        int dev = 0, cus = 0, per_cu = 0;
        hipGetDevice(&dev); hipDeviceGetAttribute(&cus, hipDeviceAttributeMultiprocessorCount, dev);
        if (hipFuncSetAttribute((const void*)fwd_megakernel, hipFuncAttributeMaxDynamicSharedMemorySize, LDS_BYTES) != hipSuccess) { fprintf(stderr, "kernel_launch: hipFuncSetAttribute failed\n"); grid = -1; return; }
        hipOccupancyMaxActiveBlocksPerMultiprocessor(&per_cu, (const void*)fwd_megakernel, 512, LDS_BYTES);
        (void)hipGetLastError();
        if (per_cu < 1) per_cu = 1;
        grid = cus * per_cu; if (grid > 256) grid = 256;
        fprintf(stderr, "kernel_launch: grid %d (cus %d per_cu %d)\n", grid, cus, per_cu);
    }
    if (grid < 0) return;
    Params p{};
    for (int i = 0; i < 19; ++i) p.in[i] = (const float*)d_in[i];
    p.out = (float*)d_out; p.ws = (unsigned char*)d_ws;
    void* args[] = {&p};
    hipError_t e = hipLaunchCooperativeKernel((const void*)fwd_megakernel, dim3(grid), dim3(512), args, LDS_BYTES, stream);
    if (e != hipSuccess) fprintf(stderr, "cooperative launch failed: %s (grid %d)\n", hipGetErrorString(e), grid);
}
```

```cpp
#include <hip/hip_runtime.h>
#include <hip/hip_cooperative_groups.h>
#include <cstdint>
#include <cstdio>
namespace cg = cooperative_groups;
#ifndef DRY_MODE
#define DRY_MODE 0
#endif
#ifndef PROBE_BLOCK
#define PROBE_BLOCK 100
#endif
#ifndef PROBE_MASK
#define PROBE_MASK 0
#endif

#define LAS __attribute__((address_space(3)))
typedef unsigned short bf16_t;
typedef short bf16x8 __attribute__((ext_vector_type(8)));
typedef short s16x4 __attribute__((ext_vector_type(4)));
typedef float f32x4 __attribute__((ext_vector_type(4)));
typedef unsigned u32x4 __attribute__((ext_vector_type(4)));
typedef unsigned u32x2 __attribute__((ext_vector_type(2)));
typedef float f32x2_t __attribute__((ext_vector_type(2)));
typedef __bf16 bf16x2_t __attribute__((ext_vector_type(2)));

constexpr int M = 16384, DM = 1024, AI = 2048, SEQ = 8192, NCH = 128;
constexpr float ALPHA = 1.681792830507429f;
constexpr size_t MiB = 1u << 20;
constexpr size_t WS_IPRE = 0, WS_LFS = 256 * 1024, WS_BCUM = 512 * 1024, WS_AARR = 768 * 1024, WS_AMAX = 1024 * 1024,
                 WS_DENSUM = 1280 * 1024, WS_ECLAMP = 1536 * 1024, WS_DEN = 1792 * 1024;
constexpr size_t WS_GNSTAT = 2 * MiB, WS_BLAST = 2 * MiB + 512 * 1024, WS_AM63 = WS_BLAST + 4096, WS_DECAY = WS_AM63 + 4096;
constexpr size_t WS_BAR = WS_DECAY + 8192;
constexpr size_t WS_KSUM = 3 * MiB, WS_SW = 5 * MiB, WS_CST = 9 * MiB, WS_NST = 17 * MiB;
constexpr size_t WS_W = 18 * MiB;
constexpr size_t WS_WXM = WS_W, WS_WV = WS_W + 4 * MiB, WS_WQK = WS_W + 6 * MiB, WS_WOUT = WS_W + 10 * MiB;
constexpr size_t WS_WZO = WS_CST;
constexpr size_t WS_XN = 32 * MiB, WS_BUF0 = 64 * MiB, WS_BUF1 = 128 * MiB, WS_BUF2 = 192 * MiB, WS_END = 256 * MiB;
constexpr size_t WS_BW0 = 64 * MiB  , WS_BVW = 70 * MiB  , WS_BO0 = 72 * MiB  , WS_BW1 = 74 * MiB  , WS_BO1 = 78 * MiB  ;
constexpr size_t WS_QB = 80 * MiB, WS_GB = 112 * MiB, WS_KB = 144 * MiB, WS_VT = 176 * MiB, WS_OG = 208 * MiB;

constexpr int LDS_BYTES = 147456;

__device__ __forceinline__ unsigned cvtpk(float lo, float hi) { f32x2_t v = {lo, hi}; bf16x2_t b = __builtin_convertvector(v, bf16x2_t); return __builtin_bit_cast(unsigned, b); }
__device__ __forceinline__ float bflo(unsigned u) { return __uint_as_float(u << 16); }
__device__ __forceinline__ float bfhi(unsigned u) { return __uint_as_float(u & 0xffff0000u); }
__device__ __forceinline__ float bf2f(unsigned short u) { return __uint_as_float(((unsigned)u) << 16); }
__device__ __forceinline__ float shfl_idx(float v, int src_lane) { return __builtin_bit_cast(float, __builtin_amdgcn_ds_bpermute(src_lane << 2, __builtin_bit_cast(int, v))); }
__device__ __forceinline__ float wave_sum(float v, int lane) {
#pragma unroll
    for (int o = 1; o < 64; o <<= 1) v += shfl_idx(v, lane ^ o);
    return v;
}
__device__ __forceinline__ int llane() { int l = (int)__builtin_amdgcn_mbcnt_hi(~0u, __builtin_amdgcn_mbcnt_lo(~0u, 0u)); asm volatile("" : "+v"(l)); return l; }
__device__ __forceinline__ float sigmoidf_(float x) { return 1.0f / (1.0f + __expf(-x)); }
__device__ __forceinline__ s16x4 tr16(const LAS unsigned char* p) { return __builtin_bit_cast(s16x4, __builtin_amdgcn_ds_read_tr16_b64_v4i16((LAS s16x4*)p)); }

namespace pg8 {
constexpr int BM = 256, BK = 64, HALF = 128, HTB = HALF * BK * 2, STAGE_BYTES = 8 * HTB, NXCD = 8, WGM = 8;
__host__ __device__ __forceinline__ int lds_byte(int r, int c) { const int st = (r >> 4) * 2 + (c >> 5), rr = r & 15, cc = c & 31, ob = rr * 64 + cc * 2; return st * 1024 + (ob ^ (((ob >> 9) & 1) << 5)); }
__host__ __device__ __forceinline__ void stage_rc(int b, int& R, int& C) { const int st = b / 1024, sb = b % 1024, swz = sb ^ (((sb >> 9) & 1) << 5); R = (st >> 1) * 16 + swz / 64; C = (st & 1) * 32 + (swz % 64) / 2; }

struct Unit { int pm, pn; const char* a; const char* b; };
struct Sched {
    int nM, nN, nwg, G, c, wid;
    const char* A; const char* B; unsigned a_tstep, b_tstep;
    int seg;
    int grp_shift; unsigned a_grp_bytes;
    __device__ __forceinline__ void init(int nM_, int nN_, int G_, int c_, const void* A_, const void* B_, int lda, int ldb, int wid_ = 0) {
        wid = wid_; nM = nM_; nN = nN_; nwg = nM * nN; G = G_; c = c_; A = (const char*)A_; B = (const char*)B_;
        a_tstep = (unsigned)(BM * lda * 2); b_tstep = (unsigned)(BM * ldb * 2); seg = -1; grp_shift = 30; a_grp_bytes = 0;
    }
    __device__ __forceinline__ bool next(int i, Unit& u) const {
        const long L = (long)i * G + c; if (L >= nwg) return false;
        int wgid = (int)L; { const int q = nwg / NXCD, r = nwg % NXCD, xcd = wgid % NXCD, off = wgid / NXCD; wgid = (xcd < r ? xcd * (q + 1) : r * (q + 1) + (xcd - r) * q) + off; }
        const int nig = WGM * nN, gid = wgid / nig, fm = gid * WGM, gsz = (nM - fm) < WGM ? (nM - fm) : WGM;
        int pmv = fm + ((wgid % nig) % gsz); u.pn = (wgid % nig) / gsz;
        u.pm = seg < 0 ? pmv : ((pmv >> 4) * 32 + 16 * seg + (pmv & 15));
        u.a = A + (size_t)((unsigned)u.pm * a_tstep + (unsigned)(u.pn >> grp_shift) * a_grp_bytes); u.b = B + (size_t)((unsigned)u.pn * b_tstep); return true;
    }
};

template <class Epi>
__device__ __forceinline__ void gemm_phase(LAS unsigned char* lds, const Sched& S, int K, int lda, int ldb, const Epi& E) {
    int wid_ = S.wid; asm volatile("" : "+s"(wid_));
    const int wid = wid_, lane = llane(), tid = wid * 64 + lane,  wr = wid >> 2, wc = wid & 3, fr = lane & 15, fq = lane >> 4;
    const int nt = K / BK;
    unsigned voffA[2], voffB[2];
#pragma unroll
    for (int i = 0; i < 2; ++i) { int R, C; stage_rc(tid * 16 + i * 8192, R, C); voffA[i] = (unsigned)(R * lda + C) * 2u; voffB[i] = (unsigned)(R * ldb + C) * 2u; }
    constexpr size_t kstep = (size_t)(BK * 2);
    const unsigned hstepA = (unsigned)(HALF * lda * 2), hstepB = (unsigned)(HALF * ldb * 2);
    const unsigned ldsw = (unsigned)wid * 1024u;
    const int aoff = lds_byte(wr * 64 + fr, fq * 8), boff = lds_byte(wc * 32 + fr, fq * 8);
#define PG8_SA(b, h) (((b) * 2 + (h)) * HTB)
#define PG8_SB(b, h) ((4 + (b) * 2 + (h)) * HTB)
#define PG8_STAGE(bufoff, gbase, voff) do { _Pragma("unroll") for (int _i = 0; _i < 2; ++_i) \
        __builtin_amdgcn_global_load_lds((const unsigned*)((const char*)(gbase) + (voff)[_i]), (LAS unsigned*)(lds + (bufoff) + ldsw + _i * 8192), 16, 0, 0); } while (0)
#define PG8_LDA(dst, b, h) do { _Pragma("unroll") for (int m = 0; m < 4; ++m) _Pragma("unroll") for (int k = 0; k < 2; ++k) dst[m][k] = *(const LAS bf16x8*)(lds + PG8_SA(b, h) + aoff + m * 2048 + k * 1024); } while (0)
#define PG8_LDB(dst, b, h) do { _Pragma("unroll") for (int n = 0; n < 2; ++n) _Pragma("unroll") for (int k = 0; k < 2; ++k) dst[n][k] = *(const LAS bf16x8*)(lds + PG8_SB(b, h) + boff + n * 2048 + k * 1024); } while (0)
#define PG8_MMA(ai, bj, At, Bt) do { __builtin_amdgcn_s_setprio(1); _Pragma("unroll") for (int m = 0; m < 4; ++m) _Pragma("unroll") for (int n = 0; n < 2; ++n) _Pragma("unroll") for (int k = 0; k < 2; ++k) \
        acc[ai][bj][m][n] = __builtin_amdgcn_mfma_f32_16x16x32_bf16(Bt[n][k], At[m][k], acc[ai][bj][m][n], 0, 0, 0); __builtin_amdgcn_s_setprio(0); } while (0)
#define PG8_WAIT_V(n) asm volatile("s_waitcnt vmcnt(" #n ")" ::: "memory")
#define PG8_WAIT_L(n) asm volatile("s_waitcnt lgkmcnt(" #n ")" ::: "memory")
#define PG8_BAR __builtin_amdgcn_s_barrier()
#define PG8_SCHED __builtin_amdgcn_sched_barrier(0)
    Unit cur, nxt; int ui = 0;
    if (!S.next(0, cur)) return;
    f32x4 acc[2][2][4][2];
#pragma unroll
    for (int a = 0; a < 2; ++a)
#pragma unroll
        for (int b = 0; b < 2; ++b)
#pragma unroll
            for (int m = 0; m < 4; ++m)
#pragma unroll
                for (int n = 0; n < 2; ++n) acc[a][b][m][n] = (f32x4){0.f, 0.f, 0.f, 0.f};
    bf16x8 At[4][2], B0[2][2], B1[2][2];
    const char* cA = cur.a; const char* cB = cur.b;
    PG8_STAGE(PG8_SB(0, 0), cB, voffB); PG8_STAGE(PG8_SB(0, 1), cB + hstepB, voffB); PG8_STAGE(PG8_SA(0, 0), cA, voffA); PG8_STAGE(PG8_SA(0, 1), cA + hstepA, voffA);
    if (wr == 1) PG8_BAR;
    PG8_WAIT_V(2); PG8_BAR;
    PG8_STAGE(PG8_SB(1, 0), cB + kstep, voffB); PG8_STAGE(PG8_SA(1, 0), cA + kstep, voffA); PG8_STAGE(PG8_SB(1, 1), cB + hstepB + kstep, voffB);
    PG8_WAIT_V(6); PG8_BAR;
    for (;;) {
        const bool has_next = S.next(ui + 1, nxt);
        const char* nA = has_next ? nxt.a : cA; const char* nB = has_next ? nxt.b : cB;
        for (int t = 0; t < nt; t += 2) {
            const bool last = (t == nt - 2);
            const char* a1 = cA + (size_t)(t + 1) * kstep;
            const char* a2 = last ? nA : cA + (size_t)(t + 2) * kstep; const char* b2 = last ? nB : cB + (size_t)(t + 2) * kstep;
            const char* a3 = a2 + kstep; const char* b3 = b2 + kstep;
            PG8_LDB(B0, 0, 0); PG8_LDB(B1, 0, 1); PG8_SCHED; PG8_LDA(At, 0, 0); PG8_STAGE(PG8_SA(1, 1), a1 + hstepA, voffA);
            PG8_WAIT_V(8); PG8_WAIT_L(0); PG8_BAR; PG8_MMA(0, 0, At, B0); PG8_MMA(0, 1, At, B1); PG8_BAR; PG8_SCHED;
            PG8_LDA(At, 0, 1); PG8_STAGE(PG8_SB(0, 0), b2, voffB); PG8_STAGE(PG8_SB(0, 1), b2 + hstepB, voffB); PG8_STAGE(PG8_SA(0, 0), a2, voffA);
            PG8_WAIT_V(8); PG8_WAIT_L(0); PG8_BAR; PG8_MMA(1, 0, At, B0); PG8_MMA(1, 1, At, B1); PG8_BAR; PG8_SCHED;
            PG8_LDB(B0, 1, 0); PG8_LDB(B1, 1, 1); PG8_SCHED; PG8_LDA(At, 1, 0); PG8_STAGE(PG8_SA(0, 1), a2 + hstepA, voffA);
            PG8_WAIT_V(8); PG8_WAIT_L(0); PG8_BAR; PG8_MMA(0, 0, At, B0); PG8_MMA(0, 1, At, B1); PG8_BAR; PG8_SCHED;
            PG8_LDA(At, 1, 1); PG8_STAGE(PG8_SB(1, 0), b3, voffB); PG8_STAGE(PG8_SB(1, 1), b3 + hstepB, voffB); PG8_STAGE(PG8_SA(1, 0), a3, voffA);
            PG8_WAIT_V(8); PG8_WAIT_L(0); PG8_BAR; PG8_MMA(1, 0, At, B0); PG8_MMA(1, 1, At, B1); PG8_BAR; PG8_SCHED;
        }
        if (wr == 0) PG8_BAR;
        E(acc, cur, wr, wc, fr, fq);
        if (!has_next) break;
#pragma unroll
        for (int a = 0; a < 2; ++a)
#pragma unroll
            for (int b = 0; b < 2; ++b)
#pragma unroll
                for (int m = 0; m < 4; ++m)
#pragma unroll
                    for (int n = 0; n < 2; ++n) acc[a][b][m][n] = (f32x4){0.f, 0.f, 0.f, 0.f};
        cur = nxt; cA = nA; cB = nB; ++ui;
        if (wr == 1) PG8_BAR;
    }
    PG8_WAIT_V(0);
    PG8_BAR;
#undef PG8_SA
#undef PG8_SB
#undef PG8_STAGE
#undef PG8_LDA
#undef PG8_LDB
#undef PG8_MMA
#undef PG8_WAIT_V
#undef PG8_WAIT_L
#undef PG8_BAR
#undef PG8_SCHED
}
}
using pg8::Unit; using pg8::Sched;

#define EPI_LOOP_BEGIN \
    _Pragma("unroll") for (int ai = 0; ai < 2; ++ai) _Pragma("unroll") for (int m = 0; m < 4; ++m) { const int row = u.pm * 256 + ai * 128 + wr * 64 + m * 16 + fr; \
    _Pragma("unroll") for (int bj = 0; bj < 2; ++bj) _Pragma("unroll") for (int n = 0; n < 2; ++n) { const int col = u.pn * 256 + bj * 128 + wc * 32 + n * 16 + fq * 4; const f32x4 v = acc[ai][bj][m][n];
#define EPI_LOOP_END } }

struct EpiPlain { bf16_t* O; size_t ldc;
    __device__ __forceinline__ void operator()(const f32x4 (&acc)[2][2][4][2], const Unit& u, int wr, int wc, int fr, int fq) const {
        EPI_LOOP_BEGIN
            u32x2 w; w.x = cvtpk(v[0], v[1]); w.y = cvtpk(v[2], v[3]); *(u32x2*)(O + (size_t)row * ldc + col) = w;
        EPI_LOOP_END
    } };
struct EpiQK { bf16_t* Q; size_t kstride; int seg;
    __device__ __forceinline__ void operator()(const f32x4 (&acc)[2][2][4][2], const Unit& u, int wr, int wc, int fr, int fq) const {
        EPI_LOOP_BEGIN
            const int orow = (row >> 13) * 4096 + ((row & 8191) - 4096 * seg); const int head = col >> 10, e = col & 1023;
            bf16_t* dst = Q + (size_t)(e >> 9) * kstride + ((size_t)head * 8192 + orow) * 512 + (e & 511);
            u32x2 w; w.x = cvtpk(v[0], v[1]); w.y = cvtpk(v[2], v[3]); *(u32x2*)dst = w;
        EPI_LOOP_END
    } };
struct EpiSplit3 { bf16_t* O0; size_t stride;
    __device__ __forceinline__ void operator()(const f32x4 (&acc)[2][2][4][2], const Unit& u, int wr, int wc, int fr, int fq) const {
        EPI_LOOP_BEGIN
            const int t = col >> 10; bf16_t* dst = O0 + (size_t)t * stride + (size_t)row * 1024 + (col & 1023);
            u32x2 w; w.x = cvtpk(v[0], v[1]); w.y = cvtpk(v[2], v[3]); *(u32x2*)dst = w;
        EPI_LOOP_END
    } };
struct EpiResid { float* X;
    __device__ __forceinline__ void operator()(const f32x4 (&acc)[2][2][4][2], const Unit& u, int wr, int wc, int fr, int fq) const {
        float al = ALPHA; asm volatile("" : "+s"(al));
        EPI_LOOP_BEGIN
            f32x4* p = (f32x4*)(X + (size_t)row * 1024 + col); const f32x4 x = *p; *p = x * al + v;
        EPI_LOOP_END
    } };
struct EpiGate { const bf16_t* NUM; const bf16_t* XC; const float* gnstat; const float* gnw; const float* skip; bf16_t* HG;
    __device__ __forceinline__ void operator()(const f32x4 (&acc)[2][2][4][2], const Unit& u, int wr, int wc, int fr, int fq) const {
#pragma unroll
        for (int ai = 0; ai < 2; ++ai)
#pragma unroll
            for (int m = 0; m < 4; ++m) { const int row = u.pm * 256 + ai * 128 + wr * 64 + m * 16 + fr;
#pragma unroll
                for (int n = 0; n < 2; ++n) { const int c = u.pn * 128 + wc * 32 + n * 16 + fq * 4; const int head = c >> 9;
                    const f32x4 z = acc[ai][0][m][n], o = acc[ai][1][m][n];
                    const u32x2 nm = *(const u32x2*)(NUM + (size_t)row * 2048 + c), xc = *(const u32x2*)(XC + (size_t)row * 2048 + c);
                    const float mean = gnstat[((size_t)row * 4 + head) * 2], rstd = gnstat[((size_t)row * 4 + head) * 2 + 1];
                    const f32x4 gw = *(const f32x4*)(gnw + c), sk = *(const f32x4*)(skip + c);
                    const float nv[4] = {bflo(nm.x), bfhi(nm.x), bflo(nm.y), bfhi(nm.y)}, xv[4] = {bflo(xc.x), bfhi(xc.x), bflo(xc.y), bfhi(xc.y)};
                    float r[4];
#pragma unroll
                    for (int e = 0; e < 4; ++e) { const float hn = (nv[e] - mean) * rstd * gw[e]; r[e] = (sigmoidf_(o[e]) * hn + sk[e] * xv[e]) * (z[e] * sigmoidf_(z[e])); }
                    u32x2 w; w.x = cvtpk(r[0], r[1]); w.y = cvtpk(r[2], r[3]); *(u32x2*)(HG + (size_t)row * 2048 + c) = w; } }
    } };

struct Ctx { int wid, NGW; LAS unsigned char* lds; int tid, lane, gw; };
__device__ __forceinline__ Ctx relaunder(const Ctx& C0) { Ctx C = C0; asm volatile("" : "+s"(C.wid)); C.lane = llane(); C.tid = C.wid * 64 + C.lane; C.gw = blockIdx.x * 8 + C.wid; return C; }

__device__ __forceinline__ void tr_block(const float* W, int ldw, int scol, bf16_t* WT, int Kd, int drow, int k0, float scale, LAS float* scr, int lane) {
#pragma unroll 8
    for (int i = 0; i < 32; ++i) { const int kk = 2 * i + (lane >> 5); scr[kk * 33 + (lane & 31)] = W[(size_t)(k0 + kk) * ldw + scol + (lane & 31)] * scale; }
    asm volatile("s_waitcnt lgkmcnt(0)" ::: "memory");
    const int c = lane & 7;
#pragma unroll
    for (int j = 0; j < 4; ++j) { const int n = (lane >> 3) + 8 * j; const LAS float* s = scr + (8 * c) * 33 + n;
        u32x4 o; o.x = cvtpk(s[0 * 33], s[1 * 33]); o.y = cvtpk(s[2 * 33], s[3 * 33]); o.z = cvtpk(s[4 * 33], s[5 * 33]); o.w = cvtpk(s[6 * 33], s[7 * 33]);
        *(u32x4*)(WT + (size_t)(drow + n) * Kd + k0 + 8 * c) = o; }
    asm volatile("s_waitcnt lgkmcnt(0)" ::: "memory");
}
__device__ __forceinline__ void tr_matrix(const Ctx& C, const float* W, int ldw, int K, int ncols, int scol0, bf16_t* WT, int drow0, float scale) {
    LAS float* scr = (LAS float*)(C.lds + C.wid * 16384);
    const int nb = ncols / 32, items = (K / 64) * nb;
    for (int it = C.gw; it < items; it += C.NGW) { const int kb = it / nb, b = it % nb; tr_block(W, ldw, scol0 + 32 * b, WT, K, drow0 + 32 * b, 64 * kb, scale, scr, C.lane); }
}
struct AW { const float *w_in, *w_q, *w_k, *w_v, *w_out; };
__device__ __forceinline__ void convert_a_weights(const Ctx& C0, const AW& w, unsigned char* ws) {
    const Ctx C = relaunder(C0);
    tr_matrix(C, w.w_in, 6152, 1024, 2048, 0, (bf16_t*)(ws + WS_WXM), 0, 1.f);
    for (int h = 0; h < 4; ++h) {
        tr_matrix(C, w.w_v + (size_t)h * 262144, 512, 512, 512, 0, (bf16_t*)(ws + WS_WV), h * 512, 1.f);
        tr_matrix(C, w.w_q + (size_t)h * 262144, 512, 512, 512, 0, (bf16_t*)(ws + WS_WQK), h * 1024, 1.f);
        tr_matrix(C, w.w_k + (size_t)h * 262144, 512, 512, 512, 0, (bf16_t*)(ws + WS_WQK), h * 1024 + 512, 0.044194173824159216f);
    }
    tr_matrix(C, w.w_out, 1024, 2048, 1024, 0, (bf16_t*)(ws + WS_WOUT), 0, 1.f);
}
__device__ __forceinline__ void convert_zo_weights(const Ctx& C0, const float* w_in, unsigned char* ws) {
    const Ctx C = relaunder(C0);
    LAS float* scr = (LAS float*)(C.lds + C.wid * 16384);
    for (int it = C.gw; it < 2048; it += C.NGW) { const int pn = it >> 7, zo = (it >> 6) & 1, sub = it & 63, kb = sub >> 2, b = sub & 3;
        tr_block(w_in, 6152, 2048 + zo * 2048 + 128 * pn + 32 * b, (bf16_t*)(ws + WS_WZO), 1024, 256 * pn + 128 * zo + 32 * b, 64 * kb, 1.f, scr, C.lane); }
}
__device__ __forceinline__ void convert_b_weights(const Ctx& C0, const float* kv_w, const float* b_w_in, const float* b_w_out, unsigned char* ws) {
    const Ctx C = relaunder(C0);
    tr_matrix(C, b_w_in, 2048, 1024, 1024, 0, (bf16_t*)(ws + WS_BW0), 0, 0.125f);
    tr_matrix(C, b_w_in, 2048, 1024, 1024, 1024, (bf16_t*)(ws + WS_BW0), 1024, 1.f);
    tr_matrix(C, kv_w, 2048, 1024, 1024, 0, (bf16_t*)(ws + WS_BW0), 2048, 1.f);
    tr_matrix(C, kv_w, 2048, 1024, 1024, 1024, (bf16_t*)(ws + WS_BVW), 0, 1.f);
    tr_matrix(C, b_w_out, 1024, 1024, 1024, 0, (bf16_t*)(ws + WS_BO0), 0, 1.f);
    tr_matrix(C, b_w_in + (size_t)1024 * 2048, 2048, 1024, 1024, 0, (bf16_t*)(ws + WS_BW1), 0, 0.125f);
    tr_matrix(C, b_w_in + (size_t)1024 * 2048, 2048, 1024, 1024, 1024, (bf16_t*)(ws + WS_BW1), 1024, 1.f);
    tr_matrix(C, b_w_out + (size_t)1024 * 1024, 1024, 1024, 1024, 0, (bf16_t*)(ws + WS_BO1), 0, 1.f);
}

__device__ __forceinline__ void rows_ln(const Ctx& C0, const float* src, float* dst, bf16_t* xn, const float* g, const float* bta) {
    const Ctx C = relaunder(C0);
    for (int r = C.gw; r < M; r += C.NGW) {
        const f32x4* xr = (const f32x4*)(src + (size_t)r * DM) + C.lane;
        f32x4 v[4]; float s = 0.f;
#pragma unroll
        for (int j = 0; j < 4; ++j) { v[j] = xr[64 * j]; s += (v[j][0] + v[j][1]) + (v[j][2] + v[j][3]); }
        if (g) {
            const float mean = wave_sum(s, C.lane) * (1.f / DM); float s2 = 0.f;
#pragma unroll
            for (int j = 0; j < 4; ++j) { v[j] = v[j] - mean; s2 += (v[j][0] * v[j][0] + v[j][1] * v[j][1]) + (v[j][2] * v[j][2] + v[j][3] * v[j][3]); }
            const float rstd = 1.f / sqrtf(wave_sum(s2, C.lane) * (1.f / DM) + 1e-5f);
#pragma unroll
            for (int j = 0; j < 4; ++j) { const f32x4 gg = *((const f32x4*)g + C.lane + 64 * j), bb = *((const f32x4*)bta + C.lane + 64 * j); v[j] = v[j] * rstd * gg + bb; }
        }
        f32x4* o = (f32x4*)(dst + (size_t)r * DM) + C.lane; u32x2* o8 = (u32x2*)(xn + (size_t)r * DM) + C.lane;
#pragma unroll
        for (int j = 0; j < 4; ++j) { o[64 * j] = v[j]; u32x2 w; w.x = cvtpk(v[j][0], v[j][1]); w.y = cvtpk(v[j][2], v[j][3]); o8[64 * j] = w; }
    }
}

__device__ __forceinline__ void phase_a2(const Ctx& C0, const float* Xf, const float* w_in, const float* b_gate, const float* conv_w, const float* conv_b,
                                         const bf16_t* XM, bf16_t* XCb, unsigned char* ws) {
    const Ctx C = relaunder(C0);
    LAS float* Wg = (LAS float*)C.lds;
    LAS float* gl = (LAS float*)(C.lds + 32768);
    float* ipre = (float*)(ws + WS_IPRE); float* bcum = (float*)(ws + WS_BCUM); float* aarr = (float*)(ws + WS_AARR); float* amax = (float*)(ws + WS_AMAX);
    float* blast = (float*)(ws + WS_BLAST); float* am63 = (float*)(ws + WS_AM63);
    (void)ipre;
    for (int k = C.tid; k < 1024; k += 512) { const f32x4 a = *(const f32x4*)(w_in + (size_t)k * 6152 + 6144), b = *(const f32x4*)(w_in + (size_t)k * 6152 + 6148);
        *(LAS f32x4*)(Wg + k * 8) = a; *(LAS f32x4*)(Wg + k * 8 + 4) = b; }
    __syncthreads();
    for (int rb = blockIdx.x; rb < 256; rb += gridDim.x) {
        for (int i = 0; i < 8; ++i) { const int rl = 8 * C.wid + i, r = 64 * rb + rl;
            float acc[8];
#pragma unroll
            for (int g = 0; g < 8; ++g) acc[g] = 0.f;
#pragma unroll
            for (int jj = 0; jj < 4; ++jj) { const f32x4 xv = *(const f32x4*)(Xf + (size_t)r * DM + 256 * jj + 4 * C.lane);
#pragma unroll
                for (int e = 0; e < 4; ++e) { const int k = 256 * jj + 4 * C.lane + e; const f32x4 w0 = *(const LAS f32x4*)(Wg + k * 8), w1 = *(const LAS f32x4*)(Wg + k * 8 + 4);
#pragma unroll
                    for (int g = 0; g < 4; ++g) { acc[g] += xv[e] * w0[g]; acc[4 + g] += xv[e] * w1[g]; } } }
#pragma unroll
            for (int g = 0; g < 8; ++g) acc[g] = wave_sum(acc[g], C.lane);
            if (C.lane < 8) { float v = acc[0];
#pragma unroll
                for (int g = 1; g < 8; ++g) v = (C.lane == g) ? acc[g] : v;
                v += b_gate[C.lane];
                if (C.lane >= 4) v = fminf(v, 0.f) - __logf(1.0f + __expf(-fabsf(v)));
                gl[rl * 8 + C.lane] = v; }
        }
        __syncthreads();
        if (C.wid < 4) { const int h = C.wid, t = C.lane, row = 64 * rb + t;
            const float ig = gl[t * 8 + h], lf = gl[t * 8 + 4 + h];
            float bc = lf;
#pragma unroll
            for (int off = 1; off < 64; off <<= 1) { const float v = shfl_idx(bc, t - off); if (t >= off) bc += v; }
            const float a = ig - bc; float amx = a;
#pragma unroll
            for (int off = 1; off < 64; off <<= 1) { const float v = shfl_idx(amx, t - off); if (t >= off) amx = fmaxf(amx, v); }
            bcum[row * 4 + h] = bc; aarr[row * 4 + h] = a; amax[row * 4 + h] = amx;
            if (t == 63) { const int bh = (rb >> 7) * 4 + h, c = rb & 127; blast[bh * 128 + c] = bc; am63[bh * 128 + c] = amx; }
        }
        { const int cgp = C.tid & 255, hf = C.tid >> 8, c0 = 8 * cgp, r0 = 64 * rb + 32 * hf;
            float w[4][8], bs[8];
#pragma unroll
            for (int tp = 0; tp < 4; ++tp) { const f32x4 a = *(const f32x4*)(conv_w + tp * 2048 + c0), b = *(const f32x4*)(conv_w + tp * 2048 + c0 + 4);
#pragma unroll
                for (int e = 0; e < 4; ++e) { w[tp][e] = a[e]; w[tp][4 + e] = b[e]; } }
            { const f32x4 a = *(const f32x4*)(conv_b + c0), b = *(const f32x4*)(conv_b + c0 + 4);
#pragma unroll
                for (int e = 0; e < 4; ++e) { bs[e] = a[e]; bs[4 + e] = b[e]; } }
            u32x4 x0 = {0, 0, 0, 0}, x1 = x0, x2 = x0;
            if ((r0 & 8191) != 0) { x0 = *(const u32x4*)(XM + (size_t)(r0 - 3) * 2048 + c0); x1 = *(const u32x4*)(XM + (size_t)(r0 - 2) * 2048 + c0); x2 = *(const u32x4*)(XM + (size_t)(r0 - 1) * 2048 + c0); }
            for (int i = 0; i < 32; ++i) { const u32x4 x3 = *(const u32x4*)(XM + (size_t)(r0 + i) * 2048 + c0);
                float o[8];
#pragma unroll
                for (int p = 0; p < 4; ++p) {
                    o[2 * p] = bs[2 * p] + w[0][2 * p] * bflo(x0[p]) + w[1][2 * p] * bflo(x1[p]) + w[2][2 * p] * bflo(x2[p]) + w[3][2 * p] * bflo(x3[p]);
                    o[2 * p + 1] = bs[2 * p + 1] + w[0][2 * p + 1] * bfhi(x0[p]) + w[1][2 * p + 1] * bfhi(x1[p]) + w[2][2 * p + 1] * bfhi(x2[p]) + w[3][2 * p + 1] * bfhi(x3[p]); }
#pragma unroll
                for (int e = 0; e < 8; ++e) o[e] = o[e] * sigmoidf_(o[e]);
                u32x4 ov; ov.x = cvtpk(o[0], o[1]); ov.y = cvtpk(o[2], o[3]); ov.z = cvtpk(o[4], o[5]); ov.w = cvtpk(o[6], o[7]);
                *(u32x4*)(XCb + (size_t)(r0 + i) * 2048 + c0) = ov; x0 = x1; x1 = x2; x2 = x3; }
        }
        __syncthreads();
    }
}

__device__ __forceinline__ void phase_pa(const Ctx& C0, int seg, bf16_t* Qs, bf16_t* Ks, unsigned char* ws) {
    const Ctx C = relaunder(C0);
    constexpr int RS = 1040;
    LAS unsigned char* Qt = C.lds; LAS unsigned char* Kt = C.lds + 64 * RS;
    LAS float* sa = (LAS float*)(C.lds + 2 * 64 * RS); LAS float* sM = sa + 64; LAS float* swi = sa + 128; LAS float* swg = sa + 192; LAS float* dpart = sa + 256;
    const float* bcum = (const float*)(ws + WS_BCUM); const float* aarr = (const float*)(ws + WS_AARR); const float* amaxa = (const float*)(ws + WS_AMAX);
    const float* blast = (const float*)(ws + WS_BLAST); const float* am63 = (const float*)(ws + WS_AM63);
    float* decay = (float*)(ws + WS_DECAY); float* densum = (float*)(ws + WS_DENSUM); float* eclamp = (float*)(ws + WS_ECLAMP); float* ksum = (float*)(ws + WS_KSUM);
    bf16_t* SW = (bf16_t*)(ws + WS_SW);
    const int lane = C.lane, m = lane & 15, q = lane >> 4, w = C.wid;
    for (int ul = blockIdx.x; ul < 512; ul += gridDim.x) {
        const int bh = ul >> 6, cl = ul & 63, c = seg * 64 + cl, b = bh >> 2, h = bh & 3;
        const int srow0 = b * 4096 + cl * 64, row0 = b * 8192 + c * 64, ug = bh * 128 + c;
#pragma unroll
        for (int i = 0; i < 8; ++i) { const int id = C.tid + 512 * i, r = id >> 6, ch = id & 63;
            const u32x4 qv = *(const u32x4*)(Qs + ((size_t)h * 8192 + srow0 + r) * 512 + ch * 8), kv = *(const u32x4*)(Ks + ((size_t)h * 8192 + srow0 + r) * 512 + ch * 8);
            *(LAS u32x4*)(Qt + r * RS + ch * 16) = qv; *(LAS u32x4*)(Kt + r * RS + ch * 16) = kv; }
        if (w == 0) {
            float a1 = blast[bh * 128 + lane], b1 = am63[bh * 128 + lane] + a1, a2 = blast[bh * 128 + 64 + lane], b2 = am63[bh * 128 + 64 + lane] + a2;
#pragma unroll
            for (int off = 1; off < 64; off <<= 1) { const float pa1 = shfl_idx(a1, lane - off), pb1 = shfl_idx(b1, lane - off), pa2 = shfl_idx(a2, lane - off), pb2 = shfl_idx(b2, lane - off);
                if (lane >= off) { b1 = fmaxf(pb1 + a1, b1); a1 = pa1 + a1; b2 = fmaxf(pb2 + a2, b2); a2 = pa2 + a2; } }
            const float A63 = shfl_idx(a1, 63), B63 = shfl_idx(b1, 63);
            float mp = 0.f;
            if (c > 0 && c <= 64) { const float A = shfl_idx(a1, c - 1), B = shfl_idx(b1, c - 1); mp = fmaxf(A, B); }
            else if (c > 64) { const float A2 = shfl_idx(a2, c - 65), B2 = shfl_idx(b2, c - 65); mp = fmaxf(A63 + A2, fmaxf(B63 + A2, B2)); }
            const int t = lane; const float a_t = aarr[(row0 + t) * 4 + h], amx = amaxa[(row0 + t) * 4 + h], bc = bcum[(row0 + t) * 4 + h];
            const float Mt = fmaxf(mp, amx), Mlast = shfl_idx(Mt, 63);
            sa[t] = a_t; sM[t] = Mt; swi[t] = __expf(mp - Mt); swg[t] = __expf(a_t - Mlast);
            eclamp[(row0 + t) * 4 + h] = __expf(-(bc + Mt));
            if (t == 0) decay[ug] = __expf(mp - Mlast);
        }
        __syncthreads();
        { const int mt = w & 3, ntp = w >> 2;
            f32x4 a0 = {0.f, 0.f, 0.f, 0.f}, a1 = a0;
            const LAS unsigned char* qp = Qt + (16 * mt + m) * RS + 16 * q; const LAS unsigned char* kp0 = Kt + (32 * ntp + m) * RS + 16 * q; const LAS unsigned char* kp1 = kp0 + 16 * RS;
#pragma unroll 4
            for (int kk = 0; kk < 16; ++kk) { const bf16x8 a = *(const LAS bf16x8*)(qp + 64 * kk), b0 = *(const LAS bf16x8*)(kp0 + 64 * kk), b1 = *(const LAS bf16x8*)(kp1 + 64 * kk);
                a0 = __builtin_amdgcn_mfma_f32_16x16x32_bf16(a, b0, a0, 0, 0, 0); a1 = __builtin_amdgcn_mfma_f32_16x16x32_bf16(a, b1, a1, 0, 0, 0); }
            float rs[4];
#pragma unroll
            for (int j = 0; j < 4; ++j) { const int t = 16 * mt + 4 * q + j, s0 = 32 * ntp + m, s1 = s0 + 16; const float Mt = sM[t];
                const float v0 = (s0 <= t) ? a0[j] * __expf(sa[s0] - Mt) : 0.f, v1 = (s1 <= t) ? a1[j] * __expf(sa[s1] - Mt) : 0.f;
                SW[(size_t)ul * 4096 + t * 64 + s0] = (bf16_t)(cvtpk(v0, 0.f) & 0xffffu); SW[(size_t)ul * 4096 + t * 64 + s1] = (bf16_t)(cvtpk(v1, 0.f) & 0xffffu);
                float r = v0 + v1; r += shfl_idx(r, lane ^ 1); r += shfl_idx(r, lane ^ 2); r += shfl_idx(r, lane ^ 4); r += shfl_idx(r, lane ^ 8); rs[j] = r; }
            if (m == 0) {
#pragma unroll
                for (int j = 0; j < 4; ++j) dpart[ntp * 64 + 16 * mt + 4 * q + j] = rs[j]; }
        }
        { const int dk = C.tid; float ks = 0.f; const LAS unsigned char* kp = Kt + dk * 2;
#pragma unroll 8
            for (int s = 0; s < 64; ++s) ks += swg[s] * bf2f(*(const LAS unsigned short*)(kp + s * RS));
            ksum[(size_t)ug * 512 + dk] = ks; }
        __syncthreads();
        if (C.tid < 64) densum[(row0 + C.tid) * 4 + h] = dpart[C.tid] + dpart[64 + C.tid];
#pragma unroll
        for (int i = 0; i < 8; ++i) { const int blk = w + 8 * i, wq = blk >> 3;
            { const int mt = (blk >> 1) & 3, ks = blk & 1, t = 16 * mt + m, dk8 = 64 * wq + 32 * ks + 8 * q;
                u32x4 qv = *(const LAS u32x4*)(Qt + t * RS + dk8 * 2); const float f = swi[t];
#pragma unroll
                for (int e = 0; e < 4; ++e) qv[e] = cvtpk(bflo(qv[e]) * f, bfhi(qv[e]) * f);
                *(u32x4*)(Qs + ((size_t)h * 8192 + srow0 + blk) * 512 + lane * 8) = qv; }
            { const int fI = blk & 7, ks = fI >> 2, hf = (fI >> 1) & 1, kss = fI & 1, dk = 64 * wq + 32 * ks + 8 * (m >> 2) + 4 * hf + (m & 3);
                float kvv[8];
#pragma unroll
                for (int jj = 0; jj < 8; ++jj) { const int s_ = 32 * kss + 8 * q + jj; kvv[jj] = swg[s_] * bf2f(*(const LAS unsigned short*)(Kt + s_ * RS + dk * 2)); }
                u32x4 kv; kv.x = cvtpk(kvv[0], kvv[1]); kv.y = cvtpk(kvv[2], kvv[3]); kv.z = cvtpk(kvv[4], kvv[5]); kv.w = cvtpk(kvv[6], kvv[7]);
                *(u32x4*)(Ks + ((size_t)h * 8192 + srow0 + blk) * 512 + lane * 8) = kv; }
        }
        __syncthreads();
    }
}

template <int MODE>
__device__ __forceinline__ void phase_pb(const Ctx& C0, int seg, const bf16_t* Qs, const bf16_t* Ks, bf16_t* V, unsigned char* ws) {
    const Ctx C = relaunder(C0);
    const float* ksum = (const float*)(ws + WS_KSUM); const float* decay = (const float*)(ws + WS_DECAY); const float* densum = (const float*)(ws + WS_DENSUM);
    const float* eclamp = (const float*)(ws + WS_ECLAMP); float* den = (float*)(ws + WS_DEN); float* Cst = (float*)(ws + WS_CST); float* nst = (float*)(ws + WS_NST);
    const bf16_t* SW = (const bf16_t*)(ws + WS_SW);
    const int lane = C.lane, m = lane & 15, q = lane >> 4, w = C.wid, tid = C.tid;
    LAS unsigned char* vs = C.lds;
    LAS float* red = (LAS float*)(C.lds + 8192);
    LAS float* redS = (LAS float*)(C.lds + 73728);
    LAS float* redq = (LAS float*)(C.lds + 90112);
    LAS float* nsl = (LAS float*)(C.lds + 92160) + w * 64;
    for (int wg = blockIdx.x; wg < 128; wg += gridDim.x) {
        const int bh = wg & 7, sl = wg >> 3, b = bh >> 2, h = bh & 3;
        f32x4 T[2][2][2]; float nv;
#pragma unroll
        for (int ks = 0; ks < 2; ++ks)
#pragma unroll
            for (int hf = 0; hf < 2; ++hf)
#pragma unroll
                for (int nt = 0; nt < 2; ++nt)
#pragma unroll
                    for (int j = 0; j < 4; ++j) { const int dk = 64 * w + 32 * ks + 8 * q + 4 * hf + j; T[ks][hf][nt][j] = seg == 0 ? 0.f : Cst[((size_t)bh * 512 + dk) * 512 + 32 * sl + 16 * nt + m]; }
        nv = seg == 0 ? 0.f : nst[bh * 512 + 64 * w + 32 * (m >> 3) + 8 * q + (m & 7)];
        const unsigned voffL = (unsigned)(lane * 16), voffV = (unsigned)((((tid & 255) >> 2) * 2048 + 8 * (tid & 3)) * 2),
                       voffS = (unsigned)((32 * (m >> 3) + 8 * q + (m & 7)) * 4), voffW = (unsigned)((m * 64 + 8 * q) * 2);
        const __amdgpu_buffer_rsrc_t rK = __builtin_amdgcn_make_buffer_rsrc((void*)Ks, 0, 0x7fffffff, 0x00020000), rQ = __builtin_amdgcn_make_buffer_rsrc((void*)Qs, 0, 0x7fffffff, 0x00020000),
                                     rV = __builtin_amdgcn_make_buffer_rsrc((void*)V, 0, 0x7fffffff, 0x00020000), rS = __builtin_amdgcn_make_buffer_rsrc((void*)ksum, 0, 0x7fffffff, 0x00020000),
                                     rW = __builtin_amdgcn_make_buffer_rsrc((void*)SW, 0, 0x7fffffff, 0x00020000);
        u32x4 X[8], Y[8], vr, swa; float ksv, dcy, dsn = 0.f, ecl = 1.f;
#define PB_LOAD_Q(cl_) do { const int qb_ = ((h * 8192 + b * 4096 + (cl_) * 64 + 8 * w) * 512) * 2; \
            _Pragma("unroll") for (int i = 0; i < 8; ++i) X[i] = __builtin_amdgcn_raw_buffer_load_b128(rQ, voffL, qb_ + i * 1024, 0); } while (0)
#define PB_LOAD_K(cl_) do { const int kb_ = ((h * 8192 + b * 4096 + (cl_) * 64 + 8 * w) * 512) * 2; \
            _Pragma("unroll") for (int i = 0; i < 8; ++i) Y[i] = __builtin_amdgcn_raw_buffer_load_b128(rK, voffL, kb_ + i * 1024, 0); } while (0)
#define PB_LOAD_Q2(cl_, i0) do { const int qb_ = ((h * 8192 + b * 4096 + (cl_) * 64 + 8 * w) * 512) * 2; \
            X[i0] = __builtin_amdgcn_raw_buffer_load_b128(rQ, voffL, qb_ + (i0) * 1024, 0); X[(i0) + 1] = __builtin_amdgcn_raw_buffer_load_b128(rQ, voffL, qb_ + ((i0) + 1) * 1024, 0); } while (0)
#define PB_LOAD_K2(cl_, i0) do { const int kb_ = ((h * 8192 + b * 4096 + (cl_) * 64 + 8 * w) * 512) * 2; \
            Y[i0] = __builtin_amdgcn_raw_buffer_load_b128(rK, voffL, kb_ + (i0) * 1024, 0); Y[(i0) + 1] = __builtin_amdgcn_raw_buffer_load_b128(rK, voffL, kb_ + ((i0) + 1) * 1024, 0); } while (0)
#define PB_LOAD_V(cl_) do { vr = __builtin_amdgcn_raw_buffer_load_b128(rV, voffV, ((b * 8192 + (seg * 64 + (cl_)) * 64) * 2048 + h * 512 + 32 * sl) * 2, 0); } while (0)
#define PB_LOAD_W(cl_) do { swa = __builtin_amdgcn_raw_buffer_load_b128(rW, voffW, ((bh * 64 + (cl_)) * 4096 + 16 * (w & 3) * 64 + 32 * (w >> 2)) * 2, 0); } while (0)
#define PB_LOAD_S(cl_) do { const int ug_ = bh * 128 + seg * 64 + (cl_); ksv = __builtin_bit_cast(float, __builtin_amdgcn_raw_buffer_load_b32(rS, voffS, (ug_ * 512 + 64 * w) * 4, 0)); dcy = decay[ug_]; } while (0)
#define PB_LOAD_D(cl_) do { if (sl == 0) { const int r_ = b * 8192 + (seg * 64 + (cl_)) * 64 + (tid >> 3); dsn = densum[r_ * 4 + h]; ecl = eclamp[r_ * 4 + h]; } } while (0)
        PB_LOAD_Q(0); PB_LOAD_K(0); PB_LOAD_V(0); PB_LOAD_W(0); PB_LOAD_S(0); PB_LOAD_D(0);
        if (tid < 256) *(LAS u32x4*)(vs + (tid >> 2) * 64 + (tid & 3) * 16) = vr;
        PB_LOAD_V(1);
        __syncthreads();
        for (int cl = 0; cl < 64; ++cl) {
            const int par = cl & 1, cln = cl < 63 ? cl + 1 : cl, cln2 = cl < 62 ? cl + 2 : 63, row0 = b * 8192 + (seg * 64 + cl) * 64;
            LAS unsigned char* vsc = vs + par * 4096;
            bf16x8 cb[2][2], nb[2], vb[2][2];
            if (MODE == 2) { unsigned acc_ = 0; _Pragma("unroll") for (int i = 0; i < 8; ++i) acc_ ^= X[i][0] ^ Y[i][1]; acc_ ^= vr[0] ^ swa[0] ^ __builtin_bit_cast(unsigned, ksv) ^ __builtin_bit_cast(unsigned, dcy); nsl[lane] = __builtin_bit_cast(float, acc_); }
            if (MODE != 2) {
            nsl[32 * (m >> 3) + 8 * q + (m & 7)] = nv;
#pragma unroll
            for (int ks = 0; ks < 2; ++ks) {
#pragma unroll
                for (int nt = 0; nt < 2; ++nt) { u32x4 pk; pk.x = cvtpk(T[ks][0][nt][0], T[ks][0][nt][1]); pk.y = cvtpk(T[ks][0][nt][2], T[ks][0][nt][3]); pk.z = cvtpk(T[ks][1][nt][0], T[ks][1][nt][1]); pk.w = cvtpk(T[ks][1][nt][2], T[ks][1][nt][3]); cb[ks][nt] = __builtin_bit_cast(bf16x8, pk); }
                const f32x4 g0 = *(const LAS f32x4*)(nsl + 32 * ks + 8 * q), g1 = *(const LAS f32x4*)(nsl + 32 * ks + 8 * q + 4);
                u32x4 pn_; pn_.x = cvtpk(g0[0], g0[1]); pn_.y = cvtpk(g0[2], g0[3]); pn_.z = cvtpk(g1[0], g1[1]); pn_.w = cvtpk(g1[2], g1[3]); if (m != 0) pn_ = (u32x4){0u, 0u, 0u, 0u}; nb[ks] = __builtin_bit_cast(bf16x8, pn_); }
#pragma unroll
            for (int kss = 0; kss < 2; ++kss)
#pragma unroll
                for (int nt = 0; nt < 2; ++nt) { const LAS unsigned char* vp = vsc + (32 * kss + 8 * q + (m >> 2)) * 64 + (16 * nt + 4 * (m & 3)) * 2; const s16x4 lo = tr16(vp), hi = tr16(vp + 4 * 64);
                    vb[kss][nt] = (bf16x8){lo[0], lo[1], lo[2], lo[3], hi[0], hi[1], hi[2], hi[3]}; }
#pragma unroll
            for (int mt = 0; mt < 4; ++mt) { const bf16x8 q0 = __builtin_bit_cast(bf16x8, X[2 * mt]), q1 = __builtin_bit_cast(bf16x8, X[2 * mt + 1]);
                f32x4 pn = {0.f, 0.f, 0.f, 0.f};
                pn = __builtin_amdgcn_mfma_f32_16x16x32_bf16(q0, nb[0], pn, 0, 0, 0); pn = __builtin_amdgcn_mfma_f32_16x16x32_bf16(q1, nb[1], pn, 0, 0, 0);
#pragma unroll
                for (int nt = 0; nt < 2; ++nt) { f32x4 p = {0.f, 0.f, 0.f, 0.f};
                    p = __builtin_amdgcn_mfma_f32_16x16x32_bf16(q0, cb[0][nt], p, 0, 0, 0); p = __builtin_amdgcn_mfma_f32_16x16x32_bf16(q1, cb[1][nt], p, 0, 0, 0);
#pragma unroll
                    for (int j = 0; j < 4; ++j) red[(w * 64 + 16 * mt + 4 * q + j) * 32 + 16 * nt + m] = p[j]; }
                if (m == 0) {
#pragma unroll
                    for (int j = 0; j < 4; ++j) redq[w * 64 + 16 * mt + 4 * q + j] = pn[j]; }
                __builtin_amdgcn_sched_barrier(0);
                if (MODE != 1) { PB_LOAD_Q2(cln, 2 * mt); }
                __builtin_amdgcn_sched_barrier(0); }
            { const int kss = w >> 2;
#pragma unroll
                for (int nt = 0; nt < 2; ++nt) { f32x4 sv = {0.f, 0.f, 0.f, 0.f};
                    sv = __builtin_amdgcn_mfma_f32_16x16x32_bf16(__builtin_bit_cast(bf16x8, swa), kss ? vb[1][nt] : vb[0][nt], sv, 0, 0, 0);
#pragma unroll
                    for (int j = 0; j < 4; ++j) redS[(kss * 64 + 16 * (w & 3) + 4 * q + j) * 32 + 16 * nt + m] = sv[j]; } }
            }
            __builtin_amdgcn_sched_barrier(0);
            if (MODE != 1) { PB_LOAD_W(cln); }
            if (tid < 256) *(LAS u32x4*)(vs + (par ^ 1) * 4096 + (tid >> 2) * 64 + (tid & 3) * 16) = vr;
            if (MODE != 1) { PB_LOAD_V(cln2); }
            __builtin_amdgcn_sched_barrier(0);
            if (MODE != 2) {
#pragma unroll
            for (int ks = 0; ks < 2; ++ks)
#pragma unroll
                for (int hf = 0; hf < 2; ++hf) {
#pragma unroll
                    for (int nt = 0; nt < 2; ++nt) { f32x4 t = T[ks][hf][nt] * dcy;
#pragma unroll
                        for (int kss = 0; kss < 2; ++kss) t = __builtin_amdgcn_mfma_f32_16x16x32_bf16(__builtin_bit_cast(bf16x8, Y[4 * ks + 2 * hf + kss]), vb[kss][nt], t, 0, 0, 0);
                        T[ks][hf][nt] = t; }
                    __builtin_amdgcn_sched_barrier(0);
                    if (MODE != 1) { PB_LOAD_K2(cln, 4 * ks + 2 * hf); }
                    __builtin_amdgcn_sched_barrier(0); }
            nv = dcy * nv + ksv;
            }
            __builtin_amdgcn_sched_barrier(0);
            if (MODE != 1) { PB_LOAD_S(cln); }
            __syncthreads();
            if (MODE != 2) { const int t_ = tid >> 3, pr_ = tid & 7; float s[4], qn = 0.f;
#pragma unroll
                for (int e = 0; e < 4; ++e) s[e] = redS[t_ * 32 + 4 * pr_ + e] + redS[(64 + t_) * 32 + 4 * pr_ + e];
#pragma unroll
                for (int ww = 0; ww < 8; ++ww) { const f32x4 rv = *(const LAS f32x4*)(red + (ww * 64 + t_) * 32 + 4 * pr_);
#pragma unroll
                    for (int e = 0; e < 4; ++e) s[e] += rv[e];
                    qn += redq[ww * 64 + t_]; }
                u32x2 ov; ov.x = cvtpk(s[0], s[1]); ov.y = cvtpk(s[2], s[3]);
                if (MODE == 0) *(u32x2*)(V + (size_t)(row0 + t_) * 2048 + h * 512 + 32 * sl + 4 * pr_) = ov;
                if (MODE == 0 && sl == 0 && pr_ == 0) { const float dn = dsn + qn; den[(row0 + t_) * 4 + h] = fmaxf(fabsf(dn), ecl); } }
            if (MODE != 1) { PB_LOAD_D(cln); }
            __syncthreads();
        }
#undef PB_LOAD_K
#undef PB_LOAD_Q
#undef PB_LOAD_V
#undef PB_LOAD_Q2
#undef PB_LOAD_K2
#undef PB_LOAD_W
#undef PB_LOAD_S
#undef PB_LOAD_D
        if (MODE == 0 && seg == 0) {
            int m2 = m; asm volatile("" : "+v"(m2));
#pragma unroll
            for (int ks = 0; ks < 2; ++ks)
#pragma unroll
                for (int hf = 0; hf < 2; ++hf)
#pragma unroll
                    for (int nt = 0; nt < 2; ++nt)
#pragma unroll
                        for (int j = 0; j < 4; ++j) { const int dk = 64 * w + 32 * ks + 8 * q + 4 * hf + j; Cst[((size_t)bh * 512 + dk) * 512 + 32 * sl + 16 * nt + m2] = T[ks][hf][nt][j]; }
            if (sl == 0) nst[bh * 512 + 64 * w + 32 * (m >> 3) + 8 * q + (m & 7)] = nv;
        }
        __syncthreads();
    }
}

__device__ __forceinline__ void phase_stats(const Ctx& C0, const bf16_t* NUM, unsigned char* ws) {
    const Ctx C = relaunder(C0);
    const float* den = (const float*)(ws + WS_DEN); float* gn = (float*)(ws + WS_GNSTAT);
    for (int it = C.gw; it < M * 4; it += C.NGW) { const int row = it >> 2, h = it & 3;
        const u32x4 raw = *(const u32x4*)(NUM + (size_t)row * 2048 + h * 512 + 8 * C.lane);
        float v[8]; float s = 0.f;
#pragma unroll
        for (int e = 0; e < 4; ++e) { v[2 * e] = bflo(raw[e]); v[2 * e + 1] = bfhi(raw[e]); s += v[2 * e] + v[2 * e + 1]; }
        const float mean = wave_sum(s, C.lane) * (1.f / 512.f); float q2 = 0.f;
#pragma unroll
        for (int e = 0; e < 8; ++e) { const float d = v[e] - mean; q2 += d * d; }
        const float var = wave_sum(q2, C.lane) * (1.f / 512.f), dn = den[it];
        if (C.lane == 0) { gn[(size_t)it * 2] = mean; gn[(size_t)it * 2 + 1] = 1.0f / sqrtf(var + 1e-6f * dn * dn); }
    }
}

__device__ __forceinline__ void phase_attn(const Ctx& C0, const bf16_t* QB, const bf16_t* KB, const bf16_t* VT, const bf16_t* GB, bf16_t* OG, const float* relb) {
    const Ctx C = relaunder(C0);
    LAS float* sb = (LAS float*)C.lds;
    for (int i = C.tid; i < 16 * 257; i += 512) sb[i] = relb[i];
    __syncthreads();
    const int lane = C.lane, n = lane & 15, q = lane >> 4;
    const int G = gridDim.x, vcu = (G % 8 == 0) ? (blockIdx.x % 8) * (G / 8) + blockIdx.x / 8 : blockIdx.x;
    for (int it = vcu * 8 + C.wid; it < 4096; it += C.NGW) {
        const int bc = (it >> 3) & 255, h = (it & 7) + 8 * (it >> 11);
        const int c = bc & 127, b = bc >> 7;
        const int qrow0 = b * 8192 + 64 * c;
        bf16x8 qf[4][2];
#pragma unroll
        for (int qb = 0; qb < 4; ++qb)
#pragma unroll
            for (int ks = 0; ks < 2; ++ks) qf[qb][ks] = *(const bf16x8*)(QB + (size_t)(qrow0 + 16 * qb + n) * 1024 + h * 64 + 32 * ks + 8 * q);
        f32x4 o[4][4]; float mrun[4], lrun[4];
#pragma unroll
        for (int qb = 0; qb < 4; ++qb) { mrun[qb] = -1e30f; lrun[qb] = 0.f;
#pragma unroll
            for (int mt = 0; mt < 4; ++mt) o[qb][mt] = (f32x4){0.f, 0.f, 0.f, 0.f}; }
        const int st0 = c < 8 ? (16 - 2 * c) : 0;
        const bf16_t* kbase = KB + (size_t)(b * 8192 + 64 * c - 512 + 8 * (n >> 2) + (n & 3)) * 1024 + h * 64 + 8 * q;
        const bf16_t* vbase = VT + (size_t)(h * 64 + n) * 16384 + b * 8192 + 64 * c - 512 + 8 * q;
        const LAS float* sbh = sb + h * 257 + 128;
        bf16x8 KA[4], KN[4], VA[4];
#define AT_LOADK(st_, KK) do { const bf16_t* kp_ = kbase + (size_t)(32 * (st_)) * 1024; \
            KK[0] = *(const bf16x8*)(kp_); KK[1] = *(const bf16x8*)(kp_ + 32); KK[2] = *(const bf16x8*)(kp_ + 4 * 1024); KK[3] = *(const bf16x8*)(kp_ + 4 * 1024 + 32); } while (0)
        AT_LOADK(st0, KA);
        for (int st = st0; st < 18; ++st) {
            const int kpos0 = 64 * c - 512 + 32 * st;
            { const bf16_t* vp_ = vbase + 32 * st;
#pragma unroll
                for (int mt = 0; mt < 4; ++mt) VA[mt] = *(const bf16x8*)(vp_ + (size_t)(16 * mt) * 16384); }
            { const int sn = st + 1 < 18 ? st + 1 : 17; AT_LOADK(sn, KN); }
#pragma unroll
            for (int qb = 0; qb < 4; ++qb) {
                f32x4 s0 = {0.f, 0.f, 0.f, 0.f}, s1 = s0;
                s0 = __builtin_amdgcn_mfma_f32_16x16x32_bf16(KA[0], qf[qb][0], s0, 0, 0, 0); s1 = __builtin_amdgcn_mfma_f32_16x16x32_bf16(KA[2], qf[qb][0], s1, 0, 0, 0);
                s0 = __builtin_amdgcn_mfma_f32_16x16x32_bf16(KA[1], qf[qb][1], s0, 0, 0, 0); s1 = __builtin_amdgcn_mfma_f32_16x16x32_bf16(KA[3], qf[qb][1], s1, 0, 0, 0);
                const int dq0 = (64 * c + 16 * qb + n) - (kpos0 + 8 * q);
                float sc[8]; float mx = -1e30f;
#pragma unroll
                for (int jj = 0; jj < 8; ++jj) { int d = dq0 - jj; d = d < -128 ? -128 : (d > 128 ? 128 : d); sc[jj] = (jj < 4 ? s0[jj & 3] : s1[jj & 3]) + sbh[d]; mx = fmaxf(mx, sc[jj]); }
                mx = fmaxf(mx, shfl_idx(mx, lane ^ 16)); mx = fmaxf(mx, shfl_idx(mx, lane ^ 32));
                const float mnew = fmaxf(mrun[qb], mx), scale = __expf(mrun[qb] - mnew);
                float ps = 0.f;
#pragma unroll
                for (int jj = 0; jj < 8; ++jj) { sc[jj] = __expf(sc[jj] - mnew); ps += sc[jj]; }
                lrun[qb] = lrun[qb] * scale + ps; mrun[qb] = mnew;
                u32x4 pk; pk.x = cvtpk(sc[0], sc[1]); pk.y = cvtpk(sc[2], sc[3]); pk.z = cvtpk(sc[4], sc[5]); pk.w = cvtpk(sc[6], sc[7]);
                const bf16x8 pb = __builtin_bit_cast(bf16x8, pk);
#pragma unroll
                for (int mt = 0; mt < 4; ++mt) { o[qb][mt] = o[qb][mt] * scale; o[qb][mt] = __builtin_amdgcn_mfma_f32_16x16x32_bf16(VA[mt], pb, o[qb][mt], 0, 0, 0); }
            }
#pragma unroll
            for (int i = 0; i < 4; ++i) KA[i] = KN[i];
        }
#undef AT_LOADK
#pragma unroll
        for (int qb = 0; qb < 4; ++qb) {
            float lt = lrun[qb] + shfl_idx(lrun[qb], lane ^ 16); lt += shfl_idx(lt, lane ^ 32);
            const float inv = 1.0f / lt;
#pragma unroll
            for (int mt = 0; mt < 4; ++mt) { const size_t off = (size_t)(qrow0 + 16 * qb + n) * 1024 + h * 64 + 16 * mt + 4 * q;
                const u32x2 g = *(const u32x2*)(GB + off); const float gv[4] = {bflo(g.x), bfhi(g.x), bflo(g.y), bfhi(g.y)};
                float r[4];
#pragma unroll
                for (int e = 0; e < 4; ++e) r[e] = o[qb][mt][e] * inv * (gv[e] * sigmoidf_(gv[e]));
                u32x2 wv; wv.x = cvtpk(r[0], r[1]); wv.y = cvtpk(r[2], r[3]); *(u32x2*)(OG + off) = wv; }
        }
    }
    __syncthreads();
}

#define XB_TMO      128
#define XB_XCNT(j)  (256  + 64 * (j))
#define XB_XSUB(j)  (1280 + 64 * (j))
#define XB_XGEN(j)  (2304 + 64 * (j))
#define XB_TOP      3328
#define XB_TOPGEN   3392
#define XCD_BAR_WORDS 3456
#define XB_SPIN_CAP (1u << 22)
__device__ __forceinline__ unsigned xb_ld(unsigned* p)              { return __hip_atomic_load(p, __ATOMIC_RELAXED, __HIP_MEMORY_SCOPE_AGENT); }
__device__ __forceinline__ unsigned xb_add(unsigned* p, unsigned v) { return __hip_atomic_fetch_add(p, v, __ATOMIC_RELAXED, __HIP_MEMORY_SCOPE_AGENT); }
__device__ __forceinline__ unsigned xb_xcc_id() { return (unsigned)__builtin_amdgcn_s_getreg((3 << 11) | 20) & 0xFu; }
#define XB_SPIN(cond, bar) do { unsigned _sp = 0; while (cond) { __builtin_amdgcn_s_sleep(1); \
    if ((++_sp & 255u) == 0u) { if (xb_ld(&(bar)[XB_TMO])) break; if (_sp > XB_SPIN_CAP) { atomicAdd(&(bar)[XB_TMO], 1u); break; } } } } while (0)
struct XcdBarrier { unsigned* bar; unsigned x; volatile LAS unsigned* st; };
__device__ __forceinline__ XcdBarrier xcd_barrier_post(unsigned* bar, volatile LAS unsigned* st) {
    XcdBarrier b; b.bar = bar; b.x = xb_xcc_id(); b.st = st;
    return b;
}
__device__ __forceinline__ void xcd_barrier_complete(unsigned* bar, unsigned x, unsigned& nloc, unsigned& nx) {
    const unsigned G = gridDim.x * gridDim.y * gridDim.z;
    unsigned sum, cnt, mine, sp = 0u;
    for (;;) {
        sum = 0u; cnt = 0u; mine = 0u;
#pragma unroll
        for (unsigned j = 0; j < 16; ++j) { const unsigned c = xb_ld(&bar[XB_XCNT(j)]); sum += c; cnt += (c > 0u) ? 1u : 0u; mine = (j == x) ? c : mine; }
        if (sum == G) break;
        __builtin_amdgcn_s_sleep(1);
        if ((++sp & 255u) == 0u) { if (xb_ld(&bar[XB_TMO])) break; if (sp > XB_SPIN_CAP) { atomicAdd(&bar[XB_TMO], 1u); break; } }
    }
    nloc = mine > 0u ? mine : 1u; nx = cnt > 0u ? cnt : 1u;
}
__device__ __forceinline__ void xcd_barrier(unsigned* bar, unsigned x, volatile LAS unsigned* st, bool t0) {
    asm volatile("s_waitcnt vmcnt(0)" ::: "memory");
    __syncthreads();
    if (t0) {
        __builtin_amdgcn_s_waitcnt(0);
        unsigned nloc = st[0], nx = st[1];
        if (nloc == 0u) { xcd_barrier_complete(bar, x, nloc, nx); st[0] = nloc; st[1] = nx; }
        const unsigned old = xb_add(&bar[XB_XSUB(x)], 1u);
        const unsigned gen = old / nloc;
        if (old + 1u == (gen + 1u) * nloc) {
            __builtin_amdgcn_fence(__ATOMIC_RELEASE, "agent");
            asm volatile("s_waitcnt vmcnt(0)" ::: "memory");
            const unsigned og = xb_add(&bar[XB_TOP], 1u);
            const unsigned tg = og / nx;
            if (og + 1u == (tg + 1u) * nx) xb_add(&bar[XB_TOPGEN], 1u);
            else XB_SPIN(xb_ld(&bar[XB_TOPGEN]) == tg, bar);
            __builtin_amdgcn_fence(__ATOMIC_ACQUIRE, "agent");
            xb_add(&bar[XB_XGEN(x)], 1u);
            asm volatile("s_waitcnt vmcnt(0)" ::: "memory");
        } else {
            XB_SPIN(xb_ld(&bar[XB_XGEN(x)]) == gen, bar);
            __builtin_amdgcn_fence(__ATOMIC_ACQUIRE, "agent");
            asm volatile("s_waitcnt vmcnt(0)" ::: "memory");
        }
    }
    __syncthreads();
}

struct Params { const float* in[19]; float* out; unsigned char* ws; };
typedef const __attribute__((address_space(4))) Params* KP;
__device__ __forceinline__ KP kargs() { KP q = (KP)__builtin_amdgcn_kernarg_segment_ptr(); asm volatile("" : "+s"(q)); return q; }

__global__ void __launch_bounds__(512) fwd_megakernel(Params p_unused) {
    extern __shared__ __attribute__((aligned(16))) unsigned char lds_raw[];
    cg::grid_group grid = cg::this_grid();
    Ctx C; C.lds = (LAS unsigned char*)lds_raw; C.wid = __builtin_amdgcn_readfirstlane((int)threadIdx.x >> 6); C.NGW = gridDim.x * 8; C.tid = 0; C.lane = 0; C.gw = 0;
#define ltid() (C.wid * 64 + llane())
    const int G = gridDim.x, cidx = blockIdx.x;
    volatile LAS unsigned long long* tl = (volatile LAS unsigned long long*)(C.lds + 140000);
    if (PROBE_MASK && ltid() == 0) tl[0] = 0ull;
#define PH(id, ...) { if (((PROBE_MASK >> (id)) & 1) && ltid() == 0) tl[1] = __builtin_amdgcn_s_memrealtime(); __VA_ARGS__ if (((PROBE_MASK >> (id)) & 1) && ltid() == 0) tl[0] += __builtin_amdgcn_s_memrealtime() - tl[1]; }
#define GSYNC() PH(6, xcd_barrier((unsigned*)(WSP + WS_BAR), xb_xcc_id(), (volatile LAS unsigned*)(C.lds + 140032), ltid() == 0);)
#define WSP (kargs()->ws)
#define INP(i) (kargs()->in[i])
#define XP (kargs()->out)
#define XNP ((bf16_t*)(WSP + WS_XN))
#define B0P ((bf16_t*)(WSP + WS_BUF0))
#define B1P ((bf16_t*)(WSP + WS_BUF1))
#define B2P ((bf16_t*)(WSP + WS_BUF2))
    if (ltid() == 0) { volatile LAS unsigned* st = (volatile LAS unsigned*)(C.lds + 140032); st[0] = 0u; st[1] = 0u; }
    if (blockIdx.x == 0) { unsigned* bar = (unsigned*)(WSP + WS_BAR); for (int i = ltid(); i < XCD_BAR_WORDS; i += 512) bar[i] = 0u; }
    __syncthreads();
    PH(5, rows_ln(C, INP(0), XP, XNP, nullptr, nullptr); { AW w{INP(1), INP(5), INP(6), INP(7), INP(10)}; convert_a_weights(C, w, WSP); })
    PH(6, grid.sync();)
    if (ltid() == 0) (void)xb_add(&((unsigned*)(WSP + WS_BAR))[XB_XCNT(xb_xcc_id())], 1u);

#pragma unroll
    for (int l = 0; l < 2; ++l) {
        PH(0, { unsigned char* ws = WSP; Sched S; S.init(64, 8, G, cidx, ws + WS_XN, ws + WS_WXM, 1024, 1024, C.wid); EpiPlain E{(bf16_t*)(ws + WS_BUF0), 2048}; pg8::gemm_phase(C.lds, S, 1024, 1024, 1024, E); })
        GSYNC();
        PH(4, phase_a2(C, XP, INP(1) + (size_t)l * 1024 * 6152, INP(2) + l * 8, INP(3) + (size_t)l * 4 * 2048, INP(4) + l * 2048, B0P, B1P, WSP);)
        PH(0, { unsigned char* ws = WSP; Sched S; S.init(64, 8, G, cidx, ws + WS_BUF0, ws + WS_WV, 2048, 512, C.wid); S.grp_shift = 1; S.a_grp_bytes = 1024; EpiPlain E{(bf16_t*)(ws + WS_BUF2), 2048}; pg8::gemm_phase(C.lds, S, 512, 2048, 512, E); })
        GSYNC();
#pragma unroll
        for (int seg = 0; seg < 2; ++seg) {
            PH(0, { unsigned char* ws = WSP; Sched S; S.init(32, 16, G, cidx, ws + WS_BUF1, ws + WS_WQK, 2048, 512, C.wid); S.seg = seg; S.grp_shift = 2; S.a_grp_bytes = 1024; EpiQK E{(bf16_t*)(ws + WS_BUF0), (size_t)8192 * 2048, seg}; pg8::gemm_phase(C.lds, S, 512, 2048, 512, E); })
            GSYNC();
            PH(2, phase_pa(C, seg, B0P, B0P + (size_t)8192 * 2048, WSP);)
            GSYNC();
            PH(1, if (DRY_MODE) phase_pb<DRY_MODE>(C, seg, B0P, B0P + (size_t)8192 * 2048, B2P, WSP); phase_pb<0>(C, seg, B0P, B0P + (size_t)8192 * 2048, B2P, WSP);)
            GSYNC();
        }
        PH(5, phase_stats(C, B2P, WSP); convert_zo_weights(C, INP(1) + (size_t)l * 1024 * 6152, WSP);)
        GSYNC();
        PH(0, { unsigned char* ws = WSP; Sched S; S.init(64, 16, G, cidx, ws + WS_XN, ws + WS_WZO, 1024, 1024, C.wid);
          EpiGate E{(bf16_t*)(ws + WS_BUF2), (bf16_t*)(ws + WS_BUF1), (const float*)(ws + WS_GNSTAT), INP(8) + l * 2048, INP(9) + l * 2048, (bf16_t*)(ws + WS_BUF0)};
          pg8::gemm_phase(C.lds, S, 1024, 1024, 1024, E); })
        GSYNC();
        PH(0, { unsigned char* ws = WSP; Sched S; S.init(64, 4, G, cidx, ws + WS_BUF0, ws + WS_WOUT, 2048, 2048, C.wid); EpiResid E{XP}; pg8::gemm_phase(C.lds, S, 2048, 2048, 2048, E); })
        GSYNC();
        PH(5, rows_ln(C, XP, XP, XNP, INP(11) + l * 1024, INP(12) + l * 1024);
        if (l == 0) { AW w{INP(1) + (size_t)1024 * 6152, INP(5) + (size_t)4 * 262144, INP(6) + (size_t)4 * 262144, INP(7) + (size_t)4 * 262144, INP(10) + (size_t)2048 * 1024}; convert_a_weights(C, w, WSP); }
        else convert_b_weights(C, INP(13), INP(14), INP(16), WSP);)
        GSYNC();
    }
#pragma unroll
    for (int l = 0; l < 2; ++l) {
        PH(0, { unsigned char* ws = WSP; Sched S; S.init(64, l == 0 ? 12 : 8, G, cidx, ws + WS_XN, ws + (l == 0 ? WS_BW0 : WS_BW1), 1024, 1024, C.wid); EpiSplit3 E{(bf16_t*)(ws + WS_QB), (size_t)16 * 1024 * 1024}; pg8::gemm_phase(C.lds, S, 1024, 1024, 1024, E); })
        PH(0, if (l == 0) { unsigned char* ws = WSP; Sched S; S.init(4, 64, G, cidx, ws + WS_BVW, ws + WS_XN, 1024, 1024, C.wid); EpiPlain E{(bf16_t*)(ws + WS_VT), 16384}; pg8::gemm_phase(C.lds, S, 1024, 1024, 1024, E); })
        GSYNC();
        PH(3, { unsigned char* ws = WSP; phase_attn(C, (const bf16_t*)(ws + WS_QB), (const bf16_t*)(ws + WS_KB), (const bf16_t*)(ws + WS_VT), (const bf16_t*)(ws + WS_GB), (bf16_t*)(ws + WS_OG), INP(15) + (size_t)l * 16 * 257); })
        GSYNC();
        PH(0, { unsigned char* ws = WSP; Sched S; S.init(64, 4, G, cidx, ws + WS_OG, ws + (l == 0 ? WS_BO0 : WS_BO1), 1024, 1024, C.wid); EpiResid E{XP}; pg8::gemm_phase(C.lds, S, 1024, 1024, 1024, E); })
        GSYNC();
        PH(5, rows_ln(C, XP, XP, XNP, INP(17) + l * 1024, INP(18) + l * 1024);)
        if (l == 0) GSYNC();
    }
    if (PROBE_MASK && blockIdx.x == PROBE_BLOCK && ltid() == 0) { const unsigned long long t0 = __builtin_amdgcn_s_memrealtime(), ta = tl[0]; while (__builtin_amdgcn_s_memrealtime() - t0 < ta) __builtin_amdgcn_s_sleep(8); }
}

extern "C" void kernel_launch(void* const* d_in, const int* in_sizes, int n_in, void* d_out, int out_size, void* d_ws, size_t ws_size, hipStream_t stream) {
    static int grid = 0;
    if (grid == 0) {
        if (n_in != 19 || out_size != M * DM || ws_size < WS_END) { fprintf(stderr, "kernel_launch: unexpected problem (n_in %d out %d ws %zu)\n", n_in, out_size, ws_size); grid = -1; return; }
        int dev = 0, cus = 0, per_cu = 0;
        hipGetDevice(&dev); hipDeviceGetAttribute(&cus, hipDeviceAttributeMultiprocessorCount, dev);
        if (hipFuncSetAttribute((const void*)fwd_megakernel, hipFuncAttributeMaxDynamicSharedMemorySize, LDS_BYTES) != hipSuccess) { fprintf(stderr, "kernel_launch: hipFuncSetAttribute failed\n"); grid = -1; return; }
        hipOccupancyMaxActiveBlocksPerMultiprocessor(&per_cu, (const void*)fwd_megakernel, 512, LDS_BYTES);
        (void)hipGetLastError();
        if (per_cu < 1) per_cu = 1;
        grid = cus * per_cu; if (grid > 256) grid = 256;
        fprintf(stderr, "kernel_launch: grid %d (cus %d per_cu %d)\n", grid, cus, per_cu);
    }
    if (grid < 0) return;
    Params p{};
    for (int i = 0; i < 19; ++i) p.in[i] = (const float*)d_in[i];
    p.out = (float*)d_out; p.ws = (unsigned char*)d_ws;
    void* args[] = {&p};
    hipError_t e = hipLaunchCooperativeKernel((const void*)fwd_megakernel, dim3(grid), dim3(512), args, LDS_BYTES, stream);
    if (e != hipSuccess) fprintf(stderr, "cooperative launch failed: %s (grid %d)\n", hipGetErrorString(e), grid);
}
```
